# Optimizing an MI355X kernel written in HIP

```python
import math
import jax, jax.numpy as jnp
from jax import lax
import numpy as np

D_MODEL = 1024
BATCH = 4
SEQ = 8192
DEPTH = 2

HEAD_DIM = 64
N_HEADS = D_MODEL // HEAD_DIM
HEADS_A = N_HEADS // 2
HEADS_B = N_HEADS - HEADS_A
KV_A = 2
KV_B = 2
G_A = HEADS_A // KV_A
G_B = HEADS_B // KV_B
Q_A = HEADS_A * HEAD_DIM
KVD_A = KV_A * HEAD_DIM
Q_B = HEADS_B * HEAD_DIM
KVD_B = KV_B * HEAD_DIM
IN_COLS = Q_A + 2 * KVD_A + Q_B + 2 * KVD_B
IN_SPLITS = (Q_A, Q_A + KVD_A, Q_A + 2 * KVD_A, Q_A + 2 * KVD_A + Q_B, Q_A + 2 * KVD_A + Q_B + KVD_B)
MIX_WIDTH = Q_A + Q_B

GRID_W = 64
ROPE_THETA = 10000.0
Q_BLOCK = 128
WINDOW = 128
N_BUCKETS = 32
MAX_DISTANCE = 128
D_FF = 2816
CONV_W = 3
ALPHA = (2.0 * DEPTH) ** 0.25
BETA = (8.0 * DEPTH) ** -0.25
RMS_EPS = 1e-6
LN_EPS = 1e-5

kernel_name = "hymba_axial_swa_convglu_deepnorm_encoder"


def rms_norm(x, g):
    xf = x.astype(jnp.float32)
    y = xf * lax.rsqrt(jnp.mean(xf * xf, axis=-1, keepdims=True) + RMS_EPS)
    return (y * g.astype(jnp.float32)).astype(x.dtype)


def layer_norm(x, g, b):
    xf = x.astype(jnp.float32)
    mu = jnp.mean(xf, axis=-1, keepdims=True)
    var = jnp.mean(jnp.square(xf - mu), axis=-1, keepdims=True)
    y = (xf - mu) * lax.rsqrt(var + LN_EPS)
    return (y * g.astype(jnp.float32) + b.astype(jnp.float32)).astype(x.dtype)


def axial_rope_tables(seq_len):
    rows_n = seq_len // GRID_W
    row = jnp.repeat(jnp.arange(rows_n, dtype=jnp.float32), GRID_W)
    col = jnp.tile(jnp.arange(GRID_W, dtype=jnp.float32), rows_n)
    half = HEAD_DIM // 2
    inv_freq = ROPE_THETA ** (-jnp.arange(0, half, 2, dtype=jnp.float32) / half)
    ang = jnp.concatenate([row[:, None] * inv_freq, col[:, None] * inv_freq], axis=-1)
    return jnp.cos(ang), jnp.sin(ang)


def apply_rope(x, cos, sin):
    xf = x.astype(jnp.float32).reshape(x.shape[:-1] + (HEAD_DIM // 2, 2))
    x0, x1 = xf[..., 0], xf[..., 1]
    c = cos[None, :, None, :]
    s = sin[None, :, None, :]
    out = jnp.stack([x0 * c - x1 * s, x0 * s + x1 * c], axis=-1).reshape(x.shape)
    return out.astype(x.dtype)


def global_gqa(q, k, v):
    B, S = q.shape[0], q.shape[1]
    nb = S // Q_BLOCK
    qb = q.reshape(B, nb, Q_BLOCK, KV_A, G_A, HEAD_DIM).transpose(1, 0, 2, 3, 4, 5)
    scale = HEAD_DIM ** -0.5

    def block(qi):
        s = jnp.einsum('bqhgd,bkhd->bhgqk', qi, k, preferred_element_type=jnp.float32) * scale
        p = jax.nn.softmax(s, axis=-1)
        return jnp.einsum('bhgqk,bkhd->bqhgd', p.astype(v.dtype), v)

    o = lax.map(block, qb)
    return o.transpose(1, 0, 2, 3, 4, 5).reshape(B, S, Q_A)


def t5_bucket(rel):
    half = N_BUCKETS // 2
    max_exact = half // 2
    bucket = jnp.where(rel > 0, half, 0)
    rp = jnp.abs(rel)
    rpf = jnp.maximum(rp, 1).astype(jnp.float32)
    large = max_exact + (jnp.log(rpf / max_exact) / math.log(MAX_DISTANCE / max_exact)
                         * (half - max_exact)).astype(jnp.int32)
    large = jnp.minimum(large, half - 1)
    return bucket + jnp.where(rp < max_exact, rp, large)


def window_gqa_sink(q, k, v, rel_bias, sink):
    B, S = q.shape[0], q.shape[1]
    nb = S // Q_BLOCK
    scale = HEAD_DIM ** -0.5
    qb = q.reshape(B, nb, Q_BLOCK, KV_B, G_B, HEAD_DIM)
    pad = ((0, 0), (Q_BLOCK, Q_BLOCK), (0, 0), (0, 0))
    kp = jnp.pad(k, pad).reshape(B, nb + 2, Q_BLOCK, KV_B, HEAD_DIM)
    vp = jnp.pad(v, pad).reshape(B, nb + 2, Q_BLOCK, KV_B, HEAD_DIM)
    kb = jnp.concatenate([kp[:, :-2], kp[:, 1:-1], kp[:, 2:]], axis=2)
    vb = jnp.concatenate([vp[:, :-2], vp[:, 1:-1], vp[:, 2:]], axis=2)
    qpos = jnp.arange(Q_BLOCK, dtype=jnp.int32)
    kpos = jnp.arange(3 * Q_BLOCK, dtype=jnp.int32) - Q_BLOCK
    rel = kpos[None, :] - qpos[:, None]
    bias = rel_bias.astype(jnp.float32)[t5_bucket(rel)]
    bias = bias.transpose(2, 0, 1).reshape(KV_B, G_B, Q_BLOCK, 3 * Q_BLOCK)
    kabs = jnp.arange(nb, dtype=jnp.int32)[:, None] * Q_BLOCK + kpos[None, :]
    valid = (jnp.abs(rel) <= WINDOW)[None] & ((kabs >= 0) & (kabs < S))[:, None, :]
    s = jnp.einsum('bnqhgd,bnkhd->bnhgqk', qb, kb, preferred_element_type=jnp.float32) * scale + bias
    s = jnp.where(valid[None, :, None, None], s, -jnp.inf)
    sink_logit = jnp.broadcast_to(sink.astype(jnp.float32).reshape(KV_B, G_B)[None, None, :, :, None, None],
                                  s.shape[:-1] + (1,))
    p = jax.nn.softmax(jnp.concatenate([s, sink_logit], axis=-1), axis=-1)[..., :-1]
    o = jnp.einsum('bnhgqk,bnkhd->bnqhgd', p.astype(v.dtype), vb)
    return o.reshape(B, S, Q_B)


def token_mixer(x, rel_bias, cos, sin, w_in, q_norm, k_norm, sink, out_norm_a, out_norm_b, w_out):
    B, S, _ = x.shape
    h = jnp.einsum('bsd,de->bse', x, w_in)
    qa, ka, va, qb, kb, vb = jnp.split(h, IN_SPLITS, axis=-1)
    qa = apply_rope(rms_norm(qa.reshape(B, S, HEADS_A, HEAD_DIM), q_norm), cos, sin)
    ka = apply_rope(rms_norm(ka.reshape(B, S, KV_A, HEAD_DIM), k_norm), cos, sin)
    va = va.reshape(B, S, KV_A, HEAD_DIM)
    ya = rms_norm(global_gqa(qa, ka, va), out_norm_a)
    yb = window_gqa_sink(qb.reshape(B, S, HEADS_B, HEAD_DIM), kb.reshape(B, S, KV_B, HEAD_DIM),
                         vb.reshape(B, S, KV_B, HEAD_DIM), rel_bias, sink)
    yb = rms_norm(yb, out_norm_b)
    return jnp.einsum('bse,ed->bsd', jnp.concatenate([ya, yb], axis=-1), w_out)


def conv_glu(x, w_gate, w_up, conv_w, conv_b, w_down):
    S = x.shape[1]
    g = jnp.einsum('bsd,df->bsf', x, w_gate)
    u = jnp.einsum('bsd,df->bsf', x, w_up)
    r = CONV_W // 2
    gp = jnp.pad(g, ((0, 0), (r, r), (0, 0)))
    gc = conv_b
    for j in range(CONV_W):
        gc = gc + gp[:, j:j + S] * conv_w[j]
    return jnp.einsum('bsf,fd->bsd', jax.nn.gelu(gc) * u, w_down)


def setup_inputs(seed: int = 0) -> dict:
    key = jax.random.key(seed)
    ks = jax.random.split(key, 20)
    f32 = jnp.float32
    L = DEPTH

    def nrm(k, shape, scale):
        return jax.random.normal(k, shape, f32) * scale

    return {
        "x": nrm(ks[0], (BATCH, SEQ, D_MODEL), 1.0),
        "rel_bias": nrm(ks[1], (N_BUCKETS, HEADS_B), 0.1),
        "w_in": nrm(ks[2], (L, D_MODEL, IN_COLS), D_MODEL ** -0.5),
        "q_norm": 1.0 + nrm(ks[3], (L, HEAD_DIM), 0.05),
        "k_norm": 1.0 + nrm(ks[4], (L, HEAD_DIM), 0.05),
        "sink": nrm(ks[5], (L, HEADS_B), 0.5),
        "out_norm_a": 1.0 + nrm(ks[6], (L, Q_A), 0.05),
        "out_norm_b": 1.0 + nrm(ks[7], (L, Q_B), 0.05),
        "w_out": nrm(ks[8], (L, MIX_WIDTH, D_MODEL), BETA * MIX_WIDTH ** -0.5),
        "ln1_g": 1.0 + nrm(ks[9], (L, D_MODEL), 0.05),
        "ln1_b": nrm(ks[10], (L, D_MODEL), 0.01),
        "w_gate": nrm(ks[11], (L, D_MODEL, D_FF), D_MODEL ** -0.5),
        "w_up": nrm(ks[12], (L, D_MODEL, D_FF), D_MODEL ** -0.5),
        "conv_w": nrm(ks[13], (L, CONV_W, D_FF), CONV_W ** -0.5),
        "conv_b": nrm(ks[14], (L, D_FF), 0.01),
        "w_down": nrm(ks[15], (L, D_FF, D_MODEL), BETA * D_FF ** -0.5),
        "ln2_g": 1.0 + nrm(ks[16], (L, D_MODEL), 0.05),
        "ln2_b": nrm(ks[17], (L, D_MODEL), 0.01),
    }


def reference(x, rel_bias, w_in, q_norm, k_norm, sink, out_norm_a, out_norm_b, w_out,
              ln1_g, ln1_b, w_gate, w_up, conv_w, conv_b, w_down, ln2_g, ln2_b):
    cos, sin = axial_rope_tables(x.shape[1])
    for l in range(DEPTH):
        mix = token_mixer(x, rel_bias, cos, sin, w_in[l], q_norm[l], k_norm[l], sink[l],
                          out_norm_a[l], out_norm_b[l], w_out[l])
        x = layer_norm(ALPHA * x + mix, ln1_g[l], ln1_b[l])
        ffn = conv_glu(x, w_gate[l], w_up[l], conv_w[l], conv_b[l], w_down[l])
        x = layer_norm(ALPHA * x + ffn, ln2_g[l], ln2_b[l])
    return x
```

```cpp
#include <hip/hip_runtime.h>
#include <hip/hip_cooperative_groups.h>
#include <hip/hip_bf16.h>
#include <cstdio>
#include <cstdint>
#include <cmath>
namespace cg = cooperative_groups;
#ifndef FFN_SCALE
#define FFN_SCALE 1.0f
#endif
namespace pg8 {
#define PG8_LAS __attribute__((address_space(3)))
typedef unsigned short bf16_t;
typedef short bf16x8 __attribute__((ext_vector_type(8)));
typedef float f32x4 __attribute__((ext_vector_type(4)));
typedef unsigned u32x4 __attribute__((ext_vector_type(4)));
constexpr int BM = 256, BK = 64, HALF = 128, HTB = HALF * BK * 2  , STAGE_BYTES = 8 * HTB, NXCD = 8, WGM = 8;

__host__ __device__ __forceinline__ int lds_byte(int r, int c) { const int st = (r >> 4) * 2 + (c >> 5), rr = r & 15, cc = c & 31, ob = rr * 64 + cc * 2; return st * 1024 + (ob ^ (((ob >> 9) & 1) << 5)); }
__host__ __device__ __forceinline__ void stage_rc(int b, int& R, int& C) { const int st = b / 1024, sb = b % 1024, swz = sb ^ (((sb >> 9) & 1) << 5); R = (st >> 1) * 16 + swz / 64; C = (st & 1) * 32 + (swz % 64) / 2; }
__host__ __device__ __forceinline__ int perm32(int rho) { const int n = rho >> 4, i = rho & 15; return 8 * (i >> 2) + 4 * n + (i & 3); }

struct Unit { int pm, pn; };
struct Gemm { const bf16_t* A; const bf16_t* Bt; int M, N, K; };

struct StaticOrder {
    int nM, nN, nwg, G, c;
    __host__ __device__ void init(int M, int N, int G_, int c_) { nM = M / BM; nN = N / BM; nwg = nM * nN; G = G_; c = c_; }
    __host__ __device__ bool next(int i, Unit& u) const {
        const long L = (long)i * G + c; if (L >= nwg) return false;
        int wgid = (int)L; { const int q = nwg / NXCD, r = nwg % NXCD, xcd = wgid % NXCD, off = wgid / NXCD; wgid = (xcd < r ? xcd * (q + 1) : r * (q + 1) + (xcd - r) * q) + off; }
        const int nig = WGM * nN, gid = wgid / nig, fm = gid * WGM, gsz = (nM - fm) < WGM ? (nM - fm) : WGM;
        u.pm = fm + ((wgid % nig) % gsz); u.pn = (wgid % nig) / gsz; return true;
    }
    __device__ __forceinline__ void a_ready(const Unit&) const {}
    __device__ __forceinline__ void done(const Unit&) const {}
};

__device__ __forceinline__ unsigned cvt_pk_bf16(float lo, float hi) { unsigned r; asm volatile("v_cvt_pk_bf16_f32 %0, %1, %2" : "=v"(r) : "v"(lo), "v"(hi)); return r; }
typedef float f32x2 __attribute__((ext_vector_type(2)));
__device__ __forceinline__ float gelu_tanh(float x) {
    const float y = 0.7978845608028654f * (x + 0.044715f * x * x * x);
    const float e = __builtin_amdgcn_exp2f(-2.8853900817779268f * y);
    return x * __builtin_amdgcn_rcpf(1.0f + e);
}
struct EpiInProj {
    static constexpr bool PERM = true, AFTER_DRAIN = false;
    bf16_t* O; int ldc; float qscale;
    __device__ __forceinline__ void operator()(const f32x4 (&acc)[2][2][4][2], const Unit& u, int wr, int wc, int fr, int fq) const {
        const int row0 = u.pm * BM + wr * 64 + fr; const int col0 = u.pn * BM + wc * 32 + 8 * fq;
        const float sc = (u.pn == 3 || u.pn == 4) ? qscale : 1.f;
#pragma unroll
        for (int ai = 0; ai < 2; ++ai)
#pragma unroll
            for (int m = 0; m < 4; ++m) { bf16_t* rowp = O + (size_t)(row0 + ai * HALF + m * 16) * ldc + col0;
#pragma unroll
                for (int bj = 0; bj < 2; ++bj) { const f32x4 v0 = acc[ai][bj][m][0] * sc, v1 = acc[ai][bj][m][1] * sc;
                    u32x4 w; w.x = cvt_pk_bf16(v0[0], v0[1]); w.y = cvt_pk_bf16(v0[2], v0[3]); w.z = cvt_pk_bf16(v1[0], v1[1]); w.w = cvt_pk_bf16(v1[2], v1[3]);
                    *(u32x4*)(rowp + bj * HALF) = w; } }
    }
};
struct EpiRes {
    static constexpr bool PERM = false, AFTER_DRAIN = false;
    const float* res; float* out; int ldc; float alpha, accs;
    __device__ __forceinline__ void operator()(const f32x4 (&acc)[2][2][4][2], const Unit& u, int wr, int wc, int fr, int fq) const {
        const int col0 = u.pn * BM + wc * 32 + 4 * fq;
#pragma unroll
        for (int ai = 0; ai < 2; ++ai)
#pragma unroll
            for (int m = 0; m < 4; ++m) { const size_t off = (size_t)(u.pm * BM + ai * HALF + wr * 64 + m * 16 + fr) * ldc + col0;
                f32x4 bs[2][2];
#pragma unroll
                for (int bj = 0; bj < 2; ++bj)
#pragma unroll
                    for (int n = 0; n < 2; ++n) bs[bj][n] = *(const f32x4*)(res + off + bj * HALF + n * 16);
#pragma unroll
                for (int bj = 0; bj < 2; ++bj)
#pragma unroll
                    for (int n = 0; n < 2; ++n) { const f32x4 o = bs[bj][n] * alpha + acc[ai][bj][m][n] * accs; *(f32x4*)(out + off + bj * HALF + n * 16) = o; }
                asm volatile("" ::: "memory"); }
    }
};
constexpr int FFD = 2816;
struct EpiConvGlu {
    static constexpr bool PERM = true, AFTER_DRAIN = false;
    bf16_t* HH; const float* cw; const float* cb; float* side;
    __device__ __forceinline__ void operator()(const f32x4 (&acc)[2][2][4][2], const Unit& u, int wr, int wc, int fr, int fq) const {
        const int lane = threadIdx.x & 63;
        const int f0 = u.pn * 128 + wc * 32 + 8 * fq;
        const int ldn = (lane & 48) | ((lane + 15) & 15);
        const int lup = (lane & 48) | ((lane + 1) & 15);
        f32x4 W0[2], W1[2], W2[2], BB[2];
#pragma unroll
        for (int n = 0; n < 2; ++n) { W0[n] = *(const f32x4*)(cw + f0 + 4 * n); W1[n] = *(const f32x4*)(cw + FFD + f0 + 4 * n); W2[n] = *(const f32x4*)(cw + 2 * FFD + f0 + 4 * n); BB[n] = *(const f32x4*)(cb + f0 + 4 * n); }
#pragma unroll
        for (int ai = 0; ai < 2; ++ai) {
            const int chunk = u.pm * 4 + ai * 2 + wr; const int rbase = chunk * 64;
            f32x4 RdP[2], RuC[2];
#pragma unroll
            for (int n = 0; n < 2; ++n) { RdP[n] = (f32x4){0.f, 0.f, 0.f, 0.f};
#pragma unroll
                for (int e = 0; e < 4; ++e) RuC[n][e] = __shfl(acc[ai][0][0][n][e], lup); }
#pragma unroll
            for (int m = 0; m < 4; ++m) {
                f32x4 RdC[2], RuN[2], hv[2];
#pragma unroll
                for (int n = 0; n < 2; ++n) {
#pragma unroll
                    for (int e = 0; e < 4; ++e) { RdC[n][e] = __shfl(acc[ai][0][m][n][e], ldn); RuN[n][e] = (m < 3) ? __shfl(acc[ai][0][m < 3 ? m + 1 : 3][n][e], lup) : 0.f; }
                }
                const bool top = (m == 0) && (fr == 0), bot = (m == 3) && (fr == 15);
                float* sp = side + ((size_t)(chunk * 2 + (bot ? 1 : 0)) * 3) * FFD + f0;
#pragma unroll
                for (int n = 0; n < 2; ++n) {
                    const f32x4 g = acc[ai][0][m][n], uu = acc[ai][1][m][n];
                    f32x4 prev, next;
#pragma unroll
                    for (int e = 0; e < 4; ++e) { prev[e] = (fr > 0) ? RdC[n][e] : RdP[n][e]; next[e] = (fr < 15) ? RuC[n][e] : RuN[n][e]; }
                    const f32x4 gc = BB[n] + W0[n] * prev + W1[n] * g + W2[n] * next;
#pragma unroll
                    for (int e = 0; e < 4; ++e) hv[n][e] = gelu_tanh(gc[e]) * uu[e];
                    if (top || bot) { *(f32x4*)(sp + 4 * n) = gc; *(f32x4*)(sp + FFD + 4 * n) = uu; *(f32x4*)(sp + 2 * FFD + 4 * n) = g; }
                }
                u32x4 w; w.x = cvt_pk_bf16(hv[0][0], hv[0][1]); w.y = cvt_pk_bf16(hv[0][2], hv[0][3]); w.z = cvt_pk_bf16(hv[1][0], hv[1][1]); w.w = cvt_pk_bf16(hv[1][2], hv[1][3]);
                *(u32x4*)(HH + (size_t)(rbase + m * 16 + fr) * FFD + f0) = w;
#pragma unroll
                for (int n = 0; n < 2; ++n) { RdP[n] = RdC[n]; RuC[n] = RuN[n]; }
            }
        }
    }
};
template <class Epi, class Sched, bool ALIGN_EPI = false, bool SP2 = false>
__device__ __forceinline__ void gemm_phase(PG8_LAS unsigned char* lds, const Gemm g, const Sched& S, const Epi& E) {
    int tid_ = threadIdx.x; asm volatile("" : "+v"(tid_));
    const int tid = tid_, wid = __builtin_amdgcn_readfirstlane(tid >> 6), lane = tid & 63, wr = wid >> 2, wc = wid & 3, fr = lane & 15, fq = lane >> 4;
    const int K = g.K, nt = K / BK;
    unsigned voffA[2], voffB[2];
#pragma unroll
    for (int i = 0; i < 2; ++i) { int R, C; stage_rc(tid * 16 + i * 8192, R, C); const int Rb = Epi::PERM ? ((R & ~31) + perm32(R & 31)) : R;
        voffA[i] = (unsigned)(R * K + C) * 2u; voffB[i] = (unsigned)(Rb * K + C) * 2u; }
    const size_t kstep = (size_t)(BK * 2);
    const size_t hstep = (size_t)HALF * K * 2;
    const size_t tstep = 2 * hstep;
    const unsigned ldsw = (unsigned)wid * 1024u;
    const int aoff = lds_byte(wr * 64 + fr, fq * 8), boff = lds_byte(wc * 32 + fr, fq * 8);
#define PG8_SA(b, h) (((b) * 2 + (h)) * HTB)
#define PG8_SB(b, h) ((4 + (b) * 2 + (h)) * HTB)
#define PG8_STAGE(bufoff, gbase, voff) do { _Pragma("unroll") for (int _i = 0; _i < 2; ++_i) \
        __builtin_amdgcn_global_load_lds((const unsigned*)((const char*)(gbase) + (voff)[_i]), (PG8_LAS unsigned*)(lds + (bufoff) + ldsw + _i * 8192), 16, 0, 0); } while (0)
#define PG8_LDA(dst, b, h) do { _Pragma("unroll") for (int m = 0; m < 4; ++m) _Pragma("unroll") for (int k = 0; k < 2; ++k) dst[m][k] = *(const PG8_LAS bf16x8*)(lds + PG8_SA(b, h) + aoff + m * 2048 + k * 1024); } while (0)
#define PG8_LDB(dst, b, h) do { _Pragma("unroll") for (int n = 0; n < 2; ++n) _Pragma("unroll") for (int k = 0; k < 2; ++k) dst[n][k] = *(const PG8_LAS bf16x8*)(lds + PG8_SB(b, h) + boff + n * 2048 + k * 1024); } while (0)
#define PG8_MMA(ai, bj, At, Bt) do { __builtin_amdgcn_s_setprio(1); _Pragma("unroll") for (int m = 0; m < 4; ++m) _Pragma("unroll") for (int n = 0; n < 2; ++n) _Pragma("unroll") for (int k = 0; k < 2; ++k) \
        acc[ai][bj][m][n] = __builtin_amdgcn_mfma_f32_16x16x32_bf16(Bt[n][k], At[m][k], acc[ai][bj][m][n], 0, 0, 0); __builtin_amdgcn_s_setprio(0); } while (0)
#define PG8_WAIT_V(n) asm volatile("s_waitcnt vmcnt(" #n ")" ::: "memory")
#define PG8_WAIT_L(n) asm volatile("s_waitcnt lgkmcnt(" #n ")" ::: "memory")
#define PG8_BAR __builtin_amdgcn_s_barrier()
#define PG8_SCHED __builtin_amdgcn_sched_barrier(0)
    Unit cur, nxt; int ui = 0;
    if (!S.next(0, cur)) return;
    f32x4 acc[2][2][4][2];
#pragma unroll
    for (int a = 0; a < 2; ++a)
#pragma unroll
        for (int b = 0; b < 2; ++b)
#pragma unroll
            for (int m = 0; m < 4; ++m)
#pragma unroll
                for (int n = 0; n < 2; ++n) acc[a][b][m][n] = (f32x4){0.f, 0.f, 0.f, 0.f};
    bf16x8 At[4][2], B0[2][2], B1[2][2];
    const char* cA = (const char*)g.A + (size_t)cur.pm * tstep; const char* cB = (const char*)g.Bt + (size_t)cur.pn * tstep;
    S.a_ready(cur);
    if constexpr (SP2) {
        PG8_STAGE(PG8_SB(0, 0), cB, voffB); PG8_STAGE(PG8_SB(0, 1), cB + hstep, voffB); PG8_STAGE(PG8_SA(0, 0), cA, voffA); PG8_STAGE(PG8_SA(0, 1), cA + hstep, voffA);
        if (wr == 1) PG8_BAR;
        PG8_WAIT_V(2); PG8_BAR;
        PG8_STAGE(PG8_SB(1, 0), cB + kstep, voffB); PG8_STAGE(PG8_SA(1, 0), cA + kstep, voffA); PG8_STAGE(PG8_SB(1, 1), cB + hstep + kstep, voffB);
        PG8_WAIT_V(6); PG8_BAR;
    } else {
        PG8_STAGE(PG8_SB(0, 0), cB, voffB); PG8_STAGE(PG8_SA(0, 0), cA, voffA); PG8_STAGE(PG8_SB(0, 1), cB + hstep, voffB); PG8_STAGE(PG8_SA(0, 1), cA + hstep, voffA);
        if (wr == 1) PG8_BAR;
        PG8_WAIT_V(4); PG8_BAR;
        PG8_STAGE(PG8_SB(1, 0), cB + kstep, voffB); PG8_STAGE(PG8_SA(1, 0), cA + kstep, voffA); PG8_STAGE(PG8_SB(1, 1), cB + hstep + kstep, voffB);
        PG8_WAIT_V(6); PG8_BAR;
    }
    for (;;) {
        const bool has_next = S.next(ui + 1, nxt);
        const char* nA = has_next ? (const char*)g.A + (size_t)nxt.pm * tstep : cA; const char* nB = has_next ? (const char*)g.Bt + (size_t)nxt.pn * tstep : cB;
        for (int t = 0; t < nt; t += 2) {
            const bool last = (t == nt - 2);
            const char* a1 = cA + (size_t)(t + 1) * kstep;
            const char* a2 = last ? nA : cA + (size_t)(t + 2) * kstep; const char* b2 = last ? nB : cB + (size_t)(t + 2) * kstep;
            const char* a3 = a2 + kstep; const char* b3 = b2 + kstep;
            if (last && has_next) S.a_ready(nxt);
            if constexpr (SP2) {
            PG8_LDB(B0, 0, 0); PG8_LDB(B1, 0, 1); PG8_SCHED; PG8_LDA(At, 0, 0); PG8_STAGE(PG8_SA(1, 1), a1 + hstep, voffA);
            PG8_WAIT_V(8); PG8_WAIT_L(0); PG8_BAR; PG8_MMA(0, 0, At, B0); PG8_MMA(0, 1, At, B1); PG8_BAR; PG8_SCHED;
            PG8_LDA(At, 0, 1); PG8_STAGE(PG8_SB(0, 0), b2, voffB); PG8_STAGE(PG8_SB(0, 1), b2 + hstep, voffB); PG8_STAGE(PG8_SA(0, 0), a2, voffA);
            PG8_WAIT_V(8); PG8_WAIT_L(0); PG8_BAR; PG8_MMA(1, 0, At, B0); PG8_MMA(1, 1, At, B1); PG8_BAR; PG8_SCHED;
            PG8_LDB(B0, 1, 0); PG8_LDB(B1, 1, 1); PG8_SCHED; PG8_LDA(At, 1, 0); PG8_STAGE(PG8_SA(0, 1), a2 + hstep, voffA);
            PG8_WAIT_V(8); PG8_WAIT_L(0); PG8_BAR; PG8_MMA(0, 0, At, B0); PG8_MMA(0, 1, At, B1); PG8_BAR; PG8_SCHED;
            PG8_LDA(At, 1, 1); PG8_STAGE(PG8_SB(1, 0), b3, voffB); PG8_STAGE(PG8_SB(1, 1), b3 + hstep, voffB); PG8_STAGE(PG8_SA(1, 0), a3, voffA);
            PG8_WAIT_V(8); PG8_WAIT_L(0); PG8_BAR; PG8_MMA(1, 0, At, B0); PG8_MMA(1, 1, At, B1); PG8_BAR; PG8_SCHED;
            } else {
            PG8_LDB(B0, 0, 0); PG8_SCHED; PG8_LDA(At, 0, 0); PG8_STAGE(PG8_SA(1, 1), a1 + hstep, voffA);
            PG8_WAIT_L(8); PG8_BAR; PG8_WAIT_L(0); PG8_MMA(0, 0, At, B0); PG8_BAR; PG8_SCHED;
            PG8_LDB(B1, 0, 1); PG8_STAGE(PG8_SB(0, 0), b2, voffB);
            PG8_BAR; PG8_WAIT_L(0); PG8_MMA(0, 1, At, B1); PG8_BAR;
            PG8_LDA(At, 0, 1); PG8_STAGE(PG8_SA(0, 0), a2, voffA);
            PG8_BAR; PG8_WAIT_L(0); PG8_MMA(1, 0, At, B0); PG8_BAR; PG8_SCHED;
            PG8_STAGE(PG8_SB(0, 1), b2 + hstep, voffB);
            PG8_WAIT_V(6); PG8_BAR; PG8_MMA(1, 1, At, B1); PG8_BAR;
            PG8_LDB(B0, 1, 0); PG8_SCHED; PG8_LDA(At, 1, 0); PG8_STAGE(PG8_SA(0, 1), a2 + hstep, voffA);
            PG8_WAIT_L(8); PG8_BAR; PG8_WAIT_L(0); PG8_MMA(0, 0, At, B0); PG8_BAR; PG8_SCHED;
            PG8_LDB(B1, 1, 1); PG8_STAGE(PG8_SB(1, 0), b3, voffB);
            PG8_BAR; PG8_WAIT_L(0); PG8_MMA(0, 1, At, B1); PG8_BAR;
            PG8_LDA(At, 1, 1); PG8_STAGE(PG8_SA(1, 0), a3, voffA);
            PG8_BAR; PG8_WAIT_L(0); PG8_MMA(1, 0, At, B0); PG8_BAR; PG8_SCHED;
            PG8_STAGE(PG8_SB(1, 1), b3 + hstep, voffB);
            PG8_WAIT_V(6); PG8_BAR; PG8_MMA(1, 1, At, B1); PG8_BAR;
            }
        }
        if constexpr (ALIGN_EPI) { if (wr == 0) PG8_BAR; }
        if constexpr (!Epi::AFTER_DRAIN) { E(acc, cur, wr, wc, fr, fq); S.done(cur); }
        if (!has_next) break;
#pragma unroll
        for (int a = 0; a < 2; ++a)
#pragma unroll
            for (int b = 0; b < 2; ++b)
#pragma unroll
                for (int m = 0; m < 4; ++m)
#pragma unroll
                    for (int n = 0; n < 2; ++n) acc[a][b][m][n] = (f32x4){0.f, 0.f, 0.f, 0.f};
        cur = nxt; cA = nA; cB = nB; ++ui;
        if constexpr (ALIGN_EPI) { if (wr == 1) PG8_BAR; }
    }
    PG8_WAIT_V(0);
    if constexpr (!ALIGN_EPI) { if (wr == 0) PG8_BAR; }
    PG8_BAR;
    if constexpr (Epi::AFTER_DRAIN) { E.fused(acc, cur, wr, wc, fr, fq, lds, wid, lane); S.done(cur); }
#undef PG8_SA
#undef PG8_SB
#undef PG8_STAGE
#undef PG8_LDA
#undef PG8_LDB
#undef PG8_MMA
#undef PG8_WAIT_V
#undef PG8_WAIT_L
#undef PG8_BAR
#undef PG8_SCHED
}
}
namespace attn_body {
using bf16=__hip_bfloat16;
using bf16x8=__attribute__((ext_vector_type(8)))short;
using s16x4=__attribute__((ext_vector_type(4)))short;
using f32x16=__attribute__((ext_vector_type(16)))float;
using u32x4=__attribute__((ext_vector_type(4)))unsigned;
constexpr int BATCH=4,SEQ=8192,D=64,QP=1536,OP=1024;
constexpr int NW=8,QBLK=32,QB=QBLK*NW,KVBLK=64,NQB=SEQ/QB;
constexpr int TBLN=768;
__device__ __forceinline__ int crow(int r,int hi){return (r&3)+8*(r>>2)+4*hi;}
#define SBAR() __builtin_amdgcn_sched_barrier(0)
constexpr int NSLOT=3, SLOTB=8192;
constexpr int LDS_K=0, LDS_V=NSLOT*SLOTB, LDS_WS=2*NSLOT*SLOTB, LDS_OST=LDS_WS+NW*64*4, LDS_BYTES=LDS_OST+NW*4096, LDS_TBL=LDS_BYTES;
constexpr float C2=0.125f*1.4426950408889634f;
__device__ __forceinline__ void glds16(const void*gsrc,unsigned lds_dst){unsigned keep;
  asm volatile("s_mov_b32 %0, m0\n\ts_mov_b32 m0, %2\n\ts_nop 0\n\tglobal_load_lds_dwordx4 %1, off\n\ts_mov_b32 m0, %0":"=&s"(keep):"v"(gsrc),"s"(lds_dst):"memory");}
__device__ __forceinline__ float max3f(float a,float b,float c){float r;asm("v_max3_f32 %0, %1, %2, %3":"=v"(r):"v"(a),"v"(b),"v"(c));return r;}
__device__ __forceinline__ float max2f(float a,float b){float r;asm("v_max_f32_e32 %0, %1, %2":"=v"(r):"v"(a),"v"(b));return r;}
__device__ __forceinline__ float fadd_s(float a,float b){float r;asm("v_add_f32_e32 %0, %1, %2":"=v"(r):"v"(a),"v"(b));return r;}
__device__ __forceinline__ float fsub_s(float a,float b){float r;asm("v_sub_f32_e32 %0, %1, %2":"=v"(r):"v"(a),"v"(b));return r;}
typedef float f32x2_t __attribute__((ext_vector_type(2))); typedef __bf16 bf16x2_t __attribute__((ext_vector_type(2)));
__device__ __forceinline__ unsigned cvtpk_s(float lo,float hi){f32x2_t v={lo,hi};bf16x2_t b=__builtin_convertvector(v,bf16x2_t);return __builtin_bit_cast(unsigned,b);}
#define WAIT_BAR(N) asm volatile("s_waitcnt vmcnt(" #N ") lgkmcnt(0)\n\ts_barrier":::"memory")

__device__ __forceinline__ void qkt(f32x16&p0,f32x16&p1,const char*Kslot,const bf16x8*qr,const f32x16&negm,int r32,int hi){
  const char*kb=Kslot+hi*1024+r32*16;
  #pragma unroll
  for(int d0=0;d0<4;++d0){
    const bf16x8 b0=*reinterpret_cast<const bf16x8*>(kb+d0*2048);
    const bf16x8 b1=*reinterpret_cast<const bf16x8*>(kb+d0*2048+512);
    if(d0==0){p0=__builtin_amdgcn_mfma_f32_32x32x16_bf16(b0,qr[0],negm,0,0,0);p1=__builtin_amdgcn_mfma_f32_32x32x16_bf16(b1,qr[0],negm,0,0,0);}
    else{p0=__builtin_amdgcn_mfma_f32_32x32x16_bf16(b0,qr[d0],p0,0,0,0);p1=__builtin_amdgcn_mfma_f32_32x32x16_bf16(b1,qr[d0],p1,0,0,0);}}
}
typedef __attribute__((address_space(3))) const char* lds_cptr;
typedef short v4i16_t __attribute__((ext_vector_type(4)));
__device__ __forceinline__ void kload8(bf16x8*kf,lds_cptr kp){
  kf[0]=*(const __attribute__((address_space(3))) bf16x8*)(kp);      kf[1]=*(const __attribute__((address_space(3))) bf16x8*)(kp+512);
  kf[2]=*(const __attribute__((address_space(3))) bf16x8*)(kp+2048); kf[3]=*(const __attribute__((address_space(3))) bf16x8*)(kp+2560);
  kf[4]=*(const __attribute__((address_space(3))) bf16x8*)(kp+4096); kf[5]=*(const __attribute__((address_space(3))) bf16x8*)(kp+4608);
  kf[6]=*(const __attribute__((address_space(3))) bf16x8*)(kp+6144); kf[7]=*(const __attribute__((address_space(3))) bf16x8*)(kp+6656);
}
__device__ __forceinline__ void kload2(bf16x8*kf,lds_cptr kp,int j){ kf[2*j]=*(const __attribute__((address_space(3))) bf16x8*)(kp+j*2048); kf[2*j+1]=*(const __attribute__((address_space(3))) bf16x8*)(kp+j*2048+512); }
__device__ __forceinline__ s16x4 vtr(lds_cptr p){ return __builtin_bit_cast(s16x4,__builtin_amdgcn_ds_read_tr16_b64_v4i16((__attribute__((address_space(3))) v4i16_t*)p)); }
__device__ __forceinline__ float rowmax(const f32x16&p0,const f32x16&p1){
  float a=max3f(p0[0],p0[1],p1[0]),b=max3f(p0[2],p0[3],p1[1]);a=max3f(a,p1[2],p1[3]);
  #pragma unroll
  for(int r=4;r<16;r+=4){a=max3f(a,p0[r],p0[r+1]);b=max3f(b,p0[r+2],p0[r+3]);a=max3f(a,p1[r],p1[r+1]);b=max3f(b,p1[r+2],p1[r+3]);}
  const float m=max2f(a,b);
  auto rr=__builtin_amdgcn_permlane32_swap(__float_as_uint(m),__float_as_uint(m),false,false);
  return max2f(__uint_as_float(rr[0]),__uint_as_float(rr[1]));
}
__device__ __forceinline__ void pv(f32x16*o,int vb,bf16x8 pa0,bf16x8 pa1,bf16x8 pa2,bf16x8 pa3){
  #pragma unroll
  for(int d0=0;d0<2;++d0){s16x4 lo[4],hi[4];
    #pragma unroll
    for(int ks=0;ks<4;++ks){
      asm volatile("ds_read_b64_tr_b16 %0,%1 offset:%c2":"=&v"(lo[ks]):"v"(vb),"i"(d0*4096+ks*1024):"memory");
      asm volatile("ds_read_b64_tr_b16 %0,%1 offset:%c2":"=&v"(hi[ks]):"v"(vb),"i"(d0*4096+ks*1024+512):"memory");}
    asm volatile("s_waitcnt lgkmcnt(0)":::"memory");SBAR();
    #define PK(k) (bf16x8){lo[k][0],lo[k][1],lo[k][2],lo[k][3],hi[k][0],hi[k][1],hi[k][2],hi[k][3]}
    o[d0]=__builtin_amdgcn_mfma_f32_32x32x16_bf16(pa0,PK(0),o[d0],0,0,0);
    o[d0]=__builtin_amdgcn_mfma_f32_32x32x16_bf16(pa1,PK(1),o[d0],0,0,0);
    o[d0]=__builtin_amdgcn_mfma_f32_32x32x16_bf16(pa2,PK(2),o[d0],0,0,0);
    o[d0]=__builtin_amdgcn_mfma_f32_32x32x16_bf16(pa3,PK(3),o[d0],0,0,0);
    #undef PK
  }
}
#ifndef ATTN_STORE16
#define ATTN_STORE16(p,v) (*(u32x4*)(p)=(v))
#endif
template<int THRL,bool WIN> __device__ __forceinline__ void attn_unit(int b,int h,int qb,const bf16*__restrict__ Hb,bf16*O,char*shm,const float*tblG,float sinkL2){
  int tid_=threadIdx.x; asm volatile("":"+v"(tid_)); const int tid=tid_,lane=tid&63,r32=lane&31,hi=lane>>5; const int wid=__builtin_amdgcn_readfirstlane(tid>>6);
  const long rowbase=(long)b*SEQ; const int q0=qb*QB;
#ifdef DBG_CHECKS
  constexpr bool NONEG=true;
#else
  constexpr bool NONEG=WIN;
#endif
  constexpr int QC=WIN?768:0,KC=WIN?1280:512,VC=WIN?1408:640,OC=WIN?512:0;
  const int tlo=WIN?((qb==0)?2:0):0;
  const long krow0=WIN?(rowbase+q0-128+64*tlo):rowbase;
  const bf16*Qw=Hb+(rowbase+q0+wid*QBLK)*QP+QC+h*D;
  const bf16*Kh=Hb+krow0*QP+KC+(h>>2)*D,*Vh=Hb+krow0*QP+VC+(h>>2)*D;
  const unsigned lds0=(unsigned)(uintptr_t)shm;
  float*wsf=(float*)(shm+LDS_WS)+wid*64;
  const bf16*ksrc=Kh+(long)lane*QP+wid*8;
  const bf16*vsrc=Vh+(long)(16*(wid&3)+(lane>>2))*QP+(wid>>2)*32+(lane&3)*8;
  const unsigned kdst=lds0+LDS_K+wid*1024, vdst=lds0+LDS_V+wid*1024;
  #define DMA_K(t,slot) glds16(ksrc+(long)(t)*KVBLK*QP,(unsigned)__builtin_amdgcn_readfirstlane(kdst+(slot)))
  #define DMA_V(t,slot) glds16(vsrc+(long)(t)*KVBLK*QP,(unsigned)__builtin_amdgcn_readfirstlane(vdst+(slot)))
  const int vb0=(int)(lds0+LDS_V)+((lane>>4)&1)*32+(lane&3)*8+(4*hi+((lane&15)>>2))*64;
  const char*Kbase=shm+LDS_K; bf16x8 kf[8];
  const lds_cptr shm3=(lds_cptr)shm; const lds_cptr kp0=shm3+LDS_K+hi*1024+r32*16; const lds_cptr vp0=shm3+LDS_V+((lane>>4)&1)*32+(lane&3)*8+(4*hi+((lane&15)>>2))*64;
  const int NT=WIN?(8-((qb==0)?2:0)-((qb==NQB-1)?2:0)):(SEQ/KVBLK);
  const __attribute__((address_space(3))) float*tbl=(const __attribute__((address_space(3))) float*)((lds_cptr)shm+LDS_TBL);
  if constexpr(WIN){ for(int i=tid;i<TBLN;i+=NW*64){ const float v_=tblG[i]; ((__attribute__((address_space(3))) float*)((lds_cptr)shm+LDS_TBL))[i]=v_; } asm volatile("s_waitcnt vmcnt(0) lgkmcnt(0)":::"memory"); }
  DMA_K(0,0);DMA_V(0,0);DMA_K(1,SLOTB);
  bf16x8 qr[4];
  #pragma unroll
  for(int d0=0;d0<4;++d0)qr[d0]=*reinterpret_cast<const bf16x8*>(&Qw[(long)r32*QP+d0*16+hi*8]);
  float mhat=0.f,l_reg=0.f;f32x16 o[2];o[0]=f32x16{};o[1]=f32x16{};f32x16 negm=f32x16{}; if constexpr(!NONEG) asm volatile("":"+v"(negm));
  const int qrel=wid*QBLK+r32;
  const int ib=256-qrel+4*hi+64*tlo;
  #define CMASK(P0,P1,t) do{ if constexpr(NONEG&&!WIN){ _Pragma("unroll") for(int r=0;r<16;++r){ P0[r]-=mhat; P1[r]-=mhat; } } if constexpr(WIN){ const __attribute__((address_space(3))) float*tb_=tbl+ib+64*(t); _Pragma("unroll") for(int r=0;r<16;++r){ P0[r]+=tb_[(r&3)+8*(r>>2)]-mhat; P1[r]+=tb_[(r&3)+8*(r>>2)+32]-mhat; } } }while(0)
  bool resc=false;
  #define START(P0,P1) do{ const float rm=rowmax(P0,P1); resc=false; \
    { const float dl=rm; mhat=fadd_s(mhat,dl); \
      _Pragma("unroll") for(int r=0;r<16;++r){P0[r]=fsub_s(P0[r],dl);P1[r]=fsub_s(P1[r],dl);} \
      if constexpr(!NONEG){ _Pragma("unroll") for(int r=0;r<16;++r)negm[r]=-mhat; asm volatile("":"+v"(negm)); } } \
    _Pragma("unroll") for(int r=0;r<16;++r)P0[r]=__builtin_amdgcn_exp2f(P0[r]); }while(0)
  #define RESC() do{ if(resc){ asm volatile("s_waitcnt lgkmcnt(0)":::"memory"); \
      _Pragma("unroll") for(int d_=0;d_<2;++d_) _Pragma("unroll") for(int r=0;r<16;++r)o[d_][r]*=wsf[crow(r,hi)]; } }while(0)
  f32x16 pA0,pA1,pB0,pB1;
  int sl_prev=0,sl_cur=0,sl_next=SLOTB;
  #define ROT() do{sl_prev=sl_cur;sl_cur=sl_next;sl_next=(sl_next==(NSLOT-1)*SLOTB)?0:sl_next+SLOTB;}while(0)
  DMA_K(2,2*SLOTB);
  WAIT_BAR(3);
  qkt(pA0,pA1,Kbase,qr,negm,r32,hi);asm volatile("s_nop 15\n\ts_nop 7":"+v"(pA0),"+v"(pA1));CMASK(pA0,pA1,0);
  START(pA0,pA1);
  _Pragma("unroll") for(int r=0;r<16;++r)pA1[r]=__builtin_amdgcn_exp2f(pA1[r]);
  WAIT_BAR(0);
  DMA_K(3,0);DMA_V(1,SLOTB);
  ROT();
  kload8(kf,kp0+sl_cur);
  WAIT_BAR(2);
  s16x4 vlo[8],vhi[8]; u32x4 pw0,pw1,pw2,pw3;
  #define PKW(P,B) cvtpk_s(P[B],P[B+1])
  #define PAF(k) __builtin_bit_cast(bf16x8,pw##k)
  #define VFR(i) (bf16x8){vlo[i][0],vlo[i][1],vlo[i][2],vlo[i][3],vhi[i][0],vhi[i][1],vhi[i][2],vhi[i][3]}
  #define PIN(x) asm volatile("":"+v"(x))
  #define MX3(a,b,c) __builtin_fmaxf(__builtin_fmaxf((a),(b)),(c))
  #define GAPA(MF,A0,A1,A2,A3,W0,W1,PW) do{ MF; sacc+=A0; sacc+=A1; sacc+=A2; sacc+=A3; PIN(sacc); W0; W1; PIN(PW); SBAR(); }while(0)
  #define EX(v) __builtin_amdgcn_exp2f(v)
  #define GAPB(MF,X,B) do{ MF; X[B]=EX(X[B]); X[B+1]=EX(X[B+1]); X[B+2]=EX(X[B+2]); X[B+3]=EX(X[B+3]); PIN(X); SBAR(); }while(0)
  #define VRD(i) do{ vlo[i]=vtr(vp_+(((i)>>2)*4096+((i)&3)*1024)); vhi[i]=vtr(vp_+(((i)>>2)*4096+((i)&3)*1024+512)); }while(0)
  #define KRD(G,j) do{ if(G){ kload2(kf,kp0+sl_next,j); SBAR(); } }while(0)
  #define STEP(C0,C1,P0,P1,t,GK,GV,GL) do{ SBAR(); \
    const lds_cptr vp_=vp0+sl_prev; \
    VRD(0); SBAR(); float sacc=(P0[0]+P0[1]); \
    GAPA(C0=__builtin_amdgcn_mfma_f32_32x32x16_bf16(kf[0],qr[0],negm,0,0,0), P0[2],P0[3],P0[4],P0[5],     pw0[0]=PKW(P0,0), pw0[1]=PKW(P0,2), pw0); \
    VRD(4); SBAR(); GAPA(C1=__builtin_amdgcn_mfma_f32_32x32x16_bf16(kf[1],qr[0],negm,0,0,0), P0[6],P0[7],P0[8],P0[9],     pw0[2]=PKW(P0,4), pw0[3]=PKW(P0,6), pw0); \
    VRD(1); SBAR(); GAPA(C0=__builtin_amdgcn_mfma_f32_32x32x16_bf16(kf[2],qr[1],C0,0,0,0),   P0[10],P0[11],P0[12],P0[13], pw1[0]=PKW(P0,8), pw1[1]=PKW(P0,10), pw1); \
    VRD(5); SBAR(); GAPA(C1=__builtin_amdgcn_mfma_f32_32x32x16_bf16(kf[3],qr[1],C1,0,0,0),   P0[14],P0[15],P1[0],P1[1],   pw1[2]=PKW(P0,12),pw1[3]=PKW(P0,14), pw1); \
    VRD(2); SBAR(); GAPA(C0=__builtin_amdgcn_mfma_f32_32x32x16_bf16(kf[4],qr[2],C0,0,0,0),   P1[2],P1[3],P1[4],P1[5],     pw2[0]=PKW(P1,0), pw2[1]=PKW(P1,2), pw2); \
    VRD(6); SBAR(); GAPA(C1=__builtin_amdgcn_mfma_f32_32x32x16_bf16(kf[5],qr[2],C1,0,0,0),   P1[6],P1[7],P1[8],P1[9],     pw2[2]=PKW(P1,4), pw2[3]=PKW(P1,6), pw2); \
    VRD(3); SBAR(); GAPA(C0=__builtin_amdgcn_mfma_f32_32x32x16_bf16(kf[6],qr[3],C0,0,0,0),   P1[10],P1[11],P1[12],P1[13], pw3[0]=PKW(P1,8), pw3[1]=PKW(P1,10), pw3); \
    VRD(7); SBAR(); GAPA(C1=__builtin_amdgcn_mfma_f32_32x32x16_bf16(kf[7],qr[3],C1,0,0,0),   P1[14],P1[15],0.f,0.f,       pw3[2]=PKW(P1,12),pw3[3]=PKW(P1,14), pw3); \
    l_reg+=sacc; \
    if(GK){DMA_K((t)+3,sl_cur);} if(GV){DMA_V((t)+1,sl_next);} \
    CMASK(C0,C1,t); \
    { float a=MX3(C0[0],C0[1],C1[0]),b=MX3(C0[2],C0[3],C1[1]); a=MX3(a,C1[2],C1[3]); \
      _Pragma("unroll") for(int r=4;r<16;r+=4){a=MX3(a,C0[r],C0[r+1]);b=MX3(b,C0[r+2],C0[r+3]);a=MX3(a,C1[r],C1[r+1]);b=MX3(b,C1[r+2],C1[r+3]);} \
      float rm=__builtin_fmaxf(a,b); { auto rr=__builtin_amdgcn_permlane32_swap(__float_as_uint(rm),__float_as_uint(rm),false,false); rm=__builtin_fmaxf(__uint_as_float(rr[0]),__uint_as_float(rr[1])); } \
      resc=false; \
      if(__builtin_expect(__any(rm>(float)THRL),0)){ const float dl=__builtin_fmaxf(rm,0.f); mhat+=dl; \
        _Pragma("unroll") for(int r=0;r<16;++r){C0[r]-=dl;C1[r]-=dl;} \
        if constexpr(!NONEG){ _Pragma("unroll") for(int r=0;r<16;++r)negm[r]=-mhat; asm volatile("":"+v"(negm)); } \
        const float f=__builtin_amdgcn_exp2f(-dl); l_reg*=f; if(hi==0)wsf[r32]=f; resc=true; } } \
    SBAR(); \
    GAPB(o[0]=__builtin_amdgcn_mfma_f32_32x32x16_bf16(PAF(0),VFR(0),o[0],0,0,0), C0,0); \
    GAPB(o[1]=__builtin_amdgcn_mfma_f32_32x32x16_bf16(PAF(0),VFR(4),o[1],0,0,0), C0,4); \
    KRD(GL,0); GAPB(o[0]=__builtin_amdgcn_mfma_f32_32x32x16_bf16(PAF(1),VFR(1),o[0],0,0,0), C0,8); \
    KRD(GL,1); GAPB(o[1]=__builtin_amdgcn_mfma_f32_32x32x16_bf16(PAF(1),VFR(5),o[1],0,0,0), C0,12); \
    KRD(GL,2); GAPB(o[0]=__builtin_amdgcn_mfma_f32_32x32x16_bf16(PAF(2),VFR(2),o[0],0,0,0), C1,0); \
    KRD(GL,3); GAPB(o[1]=__builtin_amdgcn_mfma_f32_32x32x16_bf16(PAF(2),VFR(6),o[1],0,0,0), C1,4); \
    GAPB(o[0]=__builtin_amdgcn_mfma_f32_32x32x16_bf16(PAF(3),VFR(3),o[0],0,0,0), C1,8); \
    GAPB(o[1]=__builtin_amdgcn_mfma_f32_32x32x16_bf16(PAF(3),VFR(7),o[1],0,0,0), C1,12); \
    }while(0)
  int t=1;
  for(;t+5<NT;t+=2){
    STEP(pB0,pB1,pA0,pA1,t,true,true,true);     WAIT_BAR(2); RESC(); ROT();
    STEP(pA0,pA1,pB0,pB1,t+1,true,true,true);   WAIT_BAR(2); RESC(); ROT();
  }
  #undef CMASK
  #define CMASK(P0,P1,t) do{ if constexpr(NONEG&&!WIN){ _Pragma("unroll") for(int r=0;r<16;++r){ P0[r]-=mhat; P1[r]-=mhat; } } if constexpr(WIN){ const __attribute__((address_space(3))) float*tb_=tbl+ib+64*(t); _Pragma("unroll") for(int r=0;r<16;++r){ P0[r]+=tb_[(r&3)+8*(r>>2)]-mhat; P1[r]+=tb_[(r&3)+8*(r>>2)+32]-mhat; } } }while(0)
  #define ENDW(tt) do{ if((tt)+3<NT){WAIT_BAR(2);} else if((tt)+2<NT){WAIT_BAR(1);} else {WAIT_BAR(0);} }while(0)
  for(;t+1<NT;t+=2){
    STEP(pB0,pB1,pA0,pA1,t,(t+3<NT),(t+1<NT),(t+1<NT));       ENDW(t);   RESC(); ROT();
    STEP(pA0,pA1,pB0,pB1,t+1,(t+4<NT),(t+2<NT),(t+2<NT));     ENDW(t+1); RESC(); ROT();
  }
  STEP(pB0,pB1,pA0,pA1,NT-1,false,false,false); RESC();
  { float sacc=pB0[0]+pB0[1]; _Pragma("unroll") for(int r=2;r<16;++r)sacc+=pB0[r]; _Pragma("unroll") for(int r=0;r<16;++r)sacc+=pB1[r]; l_reg+=sacc;
    pw0=(u32x4){PKW(pB0,0),PKW(pB0,2),PKW(pB0,4),PKW(pB0,6)};pw1=(u32x4){PKW(pB0,8),PKW(pB0,10),PKW(pB0,12),PKW(pB0,14)};pw2=(u32x4){PKW(pB1,0),PKW(pB1,2),PKW(pB1,4),PKW(pB1,6)};pw3=(u32x4){PKW(pB1,8),PKW(pB1,10),PKW(pB1,12),PKW(pB1,14)};
    SBAR(); pv(o,vb0+sl_cur,PAF(0),PAF(1),PAF(2),PAF(3)); }
  #undef PKW
  #undef PAF
  #undef VFR
  #undef PIN
  #undef MX3
  #undef GAPA
  #undef GAPB
  #undef EX
  #undef VRD
  #undef KRD
  #undef STEP
  #undef ENDW
  {auto rr=__builtin_amdgcn_permlane32_swap(__float_as_uint(l_reg),__float_as_uint(l_reg),false,false);l_reg=__uint_as_float(rr[0])+__uint_as_float(rr[1]);}
  if constexpr(WIN) l_reg+=__builtin_amdgcn_exp2f(sinkL2-mhat);
  if(hi==0)wsf[32+r32]=l_reg;asm volatile("s_waitcnt lgkmcnt(0)":::"memory");
  float rli[16];
  #pragma unroll
  for(int r=0;r<16;++r)rli[r]=__builtin_amdgcn_rcpf(wsf[32+crow(r,hi)]);
  bf16*Ow=O+(rowbase+q0+wid*QBLK)*OP+OC+h*D;
  { bf16*stg=(bf16*)(shm+LDS_OST)+wid*2048;
    #pragma unroll
    for(int r=0;r<16;++r){const int orow=crow(r,hi);
      #pragma unroll
      for(int d0=0;d0<2;++d0)stg[orow*64+d0*32+r32]=__float2bfloat16(o[d0][r]*rli[r]);}
    asm volatile("s_waitcnt lgkmcnt(0)":::"memory");
    #pragma unroll
    for(int i=0;i<4;++i){const int row=i*8+(lane>>3),ch=lane&7; const u32x4 v=*(const u32x4*)(stg+row*64+ch*8); ATTN_STORE16(Ow+(long)row*OP+ch*8,v);} }
  asm volatile("s_waitcnt lgkmcnt(0)\n\ts_barrier":::"memory");
  #undef DMA_K
  #undef DMA_V
  #undef CMASK
  #undef START
  #undef RESC
  #undef ROT
}
constexpr int ATTN_LDS_BYTES=LDS_TBL+TBLN*4;
#undef SBAR
#undef WAIT_BAR
}
__device__ __forceinline__ unsigned ln_f2bf(float f) { unsigned u = __builtin_bit_cast(unsigned, f); return (u + 0x7fffu + ((u >> 16) & 1u)) >> 16; }
__device__ __forceinline__ unsigned ln_pk2(float lo, float hi) { return ln_f2bf(lo) | (ln_f2bf(hi) << 16); }
__device__ __forceinline__ void ln_rows(const float* in, float* out32, unsigned short* outbf, const float* g, const float* b, int gw, int NGW, int lane) {
    typedef float f32x4 __attribute__((ext_vector_type(4))); typedef unsigned v2u __attribute__((ext_vector_type(2)));
    f32x4 gv[4], bv[4];
#pragma unroll
    for (int j = 0; j < 4; ++j) { gv[j] = *(const f32x4*)(g + 4 * lane + 256 * j); bv[j] = *(const f32x4*)(b + 4 * lane + 256 * j); }
    for (int m = gw; m < 32768; m += NGW) {
        const float* xr = in + (size_t)m * 1024 + 4 * lane;
        f32x4 v[4]; float s = 0.f;
#pragma unroll
        for (int j = 0; j < 4; ++j) { v[j] = *(const f32x4*)(xr + 256 * j); s += (v[j][0] + v[j][1]) + (v[j][2] + v[j][3]); }
        float t = s;
#pragma unroll
        for (int o = 1; o < 64; o <<= 1) t += __shfl_xor(t, o);
        const float mean = t * (1.f / 1024.f); float s2 = 0.f;
#pragma unroll
        for (int j = 0; j < 4; ++j) { v[j] = v[j] - mean; s2 += (v[j][0] * v[j][0] + v[j][1] * v[j][1]) + (v[j][2] * v[j][2] + v[j][3] * v[j][3]); }
#pragma unroll
        for (int o = 1; o < 64; o <<= 1) s2 += __shfl_xor(s2, o);
        const float rstd = rsqrtf(s2 * (1.f / 1024.f) + 1e-5f);
        float* o32 = out32 + (size_t)m * 1024 + 4 * lane; unsigned short* o16 = outbf + (size_t)m * 1024 + 4 * lane;
#pragma unroll
        for (int j = 0; j < 4; ++j) { const f32x4 y = v[j] * rstd * gv[j] + bv[j]; *(f32x4*)(o32 + 256 * j) = y;
            v2u w; w.x = ln_pk2(y[0], y[1]); w.y = ln_pk2(y[2], y[3]);
            *(v2u*)(o16 + 256 * j) = w; }
    }
}
#define LAS __attribute__((address_space(3)))
typedef unsigned short bf16raw;
typedef unsigned v4u __attribute__((ext_vector_type(4)));
typedef unsigned v2u __attribute__((ext_vector_type(2)));
typedef float f32x4 __attribute__((ext_vector_type(4)));

constexpr int NWAVES = 8, NTHR = 512;
constexpr int BATCH = 4, SEQ = 8192, DM = 1024, M = BATCH * SEQ, INC = 1536, FF = 2816, NGU = 2 * FF, DEPTH = 2;
constexpr float ALPHA = 1.4142135623730951f;
constexpr float RMS_EPS = 1e-6f, LN_EPS = 1e-5f;
constexpr float LOG2E = 1.4426950408889634f;
constexpr int LDS_BYTES = 147456;
constexpr size_t MiB = 1u << 20;
constexpr size_t WS_TBL = 0;
constexpr size_t WS_W = 1 * MiB, W_LAYER = 22 * MiB;
constexpr size_t WO_IN = 0, WO_OUT = 3 * MiB, WO_GU = 5 * MiB, WO_DN = 16 * MiB;
constexpr size_t WS_XN = 45 * MiB;
constexpr size_t WS_X1 = 109 * MiB;
constexpr size_t WS_H = 237 * MiB;
constexpr size_t WS_Y = 333 * MiB;
constexpr size_t WS_HH = 237 * MiB;
constexpr size_t WS_SIDE = 413 * MiB;
constexpr size_t WS_END = WS_SIDE + (size_t)512 * 2 * 3 * FF * 4;
static_assert(WS_HH + (size_t)M * FF * 2 <= WS_SIDE && WS_Y + (size_t)M * DM * 2 <= WS_END && WS_H + (size_t)M * INC * 2 <= WS_Y, "ws map");

__device__ __forceinline__ unsigned f2bf(float f) { unsigned u = __builtin_bit_cast(unsigned, f); return (u + 0x7fffu + ((u >> 16) & 1u)) >> 16; }
__device__ __forceinline__ unsigned pk2(float lo, float hi) { return f2bf(lo) | (f2bf(hi) << 16); }
__device__ __forceinline__ float bf2f(unsigned short h) { return __builtin_bit_cast(float, (unsigned)h << 16); }
__device__ __forceinline__ float wave_sum(float v) {
#pragma unroll
    for (int o = 1; o < 64; o <<= 1) v += __shfl_xor(v, o);
    return v;
}

__device__ __forceinline__ void transpose_item(const float* W, int K, int N, bf16raw* WT, int k0, int n0, int dst0, LAS float* scr, int lane) {
#pragma unroll 8
    for (int i = 0; i < 32; ++i) { const int kk = 2 * i + (lane >> 5); scr[kk * 33 + (lane & 31)] = W[(size_t)(k0 + kk) * N + n0 + (lane & 31)]; }
    asm volatile("s_waitcnt lgkmcnt(0)" ::: "memory");
    const int c = lane & 7;
#pragma unroll
    for (int j = 0; j < 4; ++j) { const int n = (lane >> 3) + 8 * j; const LAS float* s = scr + (8 * c) * 33 + n;
        v4u o; o.x = pk2(s[0 * 33], s[1 * 33]); o.y = pk2(s[2 * 33], s[3 * 33]); o.z = pk2(s[4 * 33], s[5 * 33]); o.w = pk2(s[6 * 33], s[7 * 33]);
        *(v4u*)(WT + (size_t)(dst0 + n) * K + k0 + 8 * c) = o; }
    asm volatile("s_waitcnt lgkmcnt(0)" ::: "memory");
}

#ifdef DBG_CHECKS
constexpr size_t WS_FLAGS = 512 * 1024;
__device__ __forceinline__ unsigned hsh(unsigned x) { x ^= x >> 16; x *= 0x7feb352dU; x ^= x >> 15; x *= 0x846ca68bU; x ^= x >> 16; return x; }
__device__ __forceinline__ float rbf(float f) { return bf2f((unsigned short)f2bf(f)); }
__device__ __forceinline__ float dot_aw(const bf16raw* a, const float* W, int col, int N, int K, int lane) {
    float s = 0.f; for (int k = lane; k < K; k += 64) s += bf2f(a[k]) * rbf(W[(size_t)k * N + col]); return wave_sum(s);
}
__device__ __forceinline__ void flag_if(unsigned* flags, bool bad, unsigned bit, int lane) { if (bad && lane == 0) atomicOr(flags, bit); }
#endif

struct Args { const float* in[18]; float* out; unsigned char* ws; };
typedef const __attribute__((address_space(4))) Args* ArgsP;
__device__ __forceinline__ ArgsP args_ptr() { ArgsP p = (ArgsP)__builtin_amdgcn_kernarg_segment_ptr(); asm volatile("" : "+s"(p)); return p; }
#define ARGS() const ArgsP ap = args_ptr(); unsigned char* const ws = ap->ws; (void)ws

__device__ __forceinline__ int t5_bucket(int rel) {
    const int rp = rel < 0 ? -rel : rel; int v;
    if (rp < 8) v = rp; else if (rp < 12) v = 8; else if (rp < 16) v = 9; else if (rp < 23) v = 10; else if (rp < 32) v = 11; else if (rp < 46) v = 12; else if (rp < 64) v = 13; else if (rp < 91) v = 14; else v = 15;
    return (rel > 0 ? 16 : 0) + v;
}

#define GSYNC() do { __builtin_amdgcn_fence(__ATOMIC_RELEASE, "agent"); grid.sync(); __builtin_amdgcn_fence(__ATOMIC_ACQUIRE, "agent"); } while (0)
__global__ void __launch_bounds__(NTHR, 2) fwd_kernel(Args a) {
    extern __shared__ __attribute__((aligned(16))) unsigned char lds[];
    cg::grid_group grid = cg::this_grid();
    const int G = gridDim.x, bx = blockIdx.x;
    const int vcu = (G % 8 == 0) ? (bx % 8) * (G / 8) + bx / 8 : bx;
    const int NGW = G * NWAVES, NGT = G * NTHR;
#define IDS() int tid_ = threadIdx.x; asm volatile("" : "+v"(tid_)); const int tid = tid_, lane = tid & 63, wave = __builtin_amdgcn_readfirstlane(tid >> 6); const int gw = vcu * NWAVES + wave, gt = bx * NTHR + tid; (void)lane; (void)gw; (void)gt
#define XN_ ((bf16raw*)(ws + WS_XN))
#define X1_ ((float*)(ws + WS_X1))
#define HB_ ((bf16raw*)(ws + WS_H))
#define YB_ ((bf16raw*)(ws + WS_Y))
#define HH_ ((bf16raw*)(ws + WS_HH))
#define SIDE_ ((float*)(ws + WS_SIDE))
#define TBL_ ((float*)(ws + WS_TBL))
#define WL_ (ws + WS_W + (size_t)l * W_LAYER)
    LAS unsigned char* ldsp = (LAS unsigned char*)lds;

    {
        ARGS(); IDS(); const float* x_in = ap->in[0]; bf16raw* XN = XN_; float* tblG = TBL_;
        LAS float* scr = (LAS float*)((LAS unsigned char*)lds + wave * 16384);
        constexpr int I_IN = (DM / 64) * (INC / 32), I_OUT = (DM / 64) * (DM / 32), I_G = (DM / 64) * (FF / 32), I_DN = (FF / 64) * (DM / 32);
        constexpr int I_LAYER = I_IN + I_OUT + 2 * I_G + I_DN;
        for (int it = gw; it < DEPTH * I_LAYER; it += NGW) {
            const int l = it / I_LAYER; int r = it % I_LAYER;
            unsigned char* wl = ws + WS_W + (size_t)l * W_LAYER;
            if (r < I_IN) { const int nblk = INC / 32, kb = r / nblk, nb = r % nblk;
                transpose_item(ap->in[2] + (size_t)l * DM * INC, DM, INC, (bf16raw*)(wl + WO_IN), 64 * kb, 32 * nb, 32 * nb, scr, lane); continue; } r -= I_IN;
            if (r < I_OUT) { const int nblk = DM / 32, kb = r / nblk, nb = r % nblk;
                transpose_item(ap->in[8] + (size_t)l * DM * DM, DM, DM, (bf16raw*)(wl + WO_OUT), 64 * kb, 32 * nb, 32 * nb, scr, lane); continue; } r -= I_OUT;
            if (r < 2 * I_G) { const int up = r >= I_G ? 1 : 0; if (up) r -= I_G; const int nblk = FF / 32, kb = r / nblk, nb = r % nblk, n0 = 32 * nb;
                transpose_item((up ? ap->in[12] : ap->in[11]) + (size_t)l * DM * FF, DM, FF, (bf16raw*)(wl + WO_GU), 64 * kb, n0, (n0 / 128) * 256 + (n0 % 128) + up * 128, scr, lane); continue; } r -= 2 * I_G;
            { const int nblk = DM / 32, kb = r / nblk, nb = r % nblk;
                transpose_item(ap->in[15] + (size_t)l * FF * DM, FF, DM, (bf16raw*)(wl + WO_DN), 64 * kb, 32 * nb, 32 * nb, scr, lane); }
        }
        for (size_t i = gt; i < (size_t)M * DM / 8; i += NGT) {
            const f32x4 v0 = *(const f32x4*)(x_in + i * 8), v1 = *(const f32x4*)(x_in + i * 8 + 4);
            v4u o; o.x = pk2(v0[0], v0[1]); o.y = pk2(v0[2], v0[3]); o.z = pk2(v1[0], v1[1]); o.w = pk2(v1[2], v1[3]);
            *(v4u*)(XN + i * 8) = o;
        }
#ifdef DBG_CHECKS
        if (gt == 0) { *(unsigned*)(ws + WS_FLAGS) = 0u; *((unsigned*)(ws + WS_FLAGS) + 1) = 0u; *((unsigned*)(ws + WS_FLAGS) + 2) = 0u; }
#endif
        for (int i = gt; i < 8 * attn_body::TBLN; i += NGT) {
            const int h = i / attn_body::TBLN, rel = i % attn_body::TBLN - 384;
            float v = -1000.f;
            if (rel >= -128 && rel <= 128) v = ap->in[1][t5_bucket(rel) * 8 + h] * LOG2E;
            tblG[i] = v;
        }
    }
    GSYNC();

#if defined(DBG_CHECKS) && (DBG_CHECKS & 128)
    {
        ARGS(); IDS(); unsigned* flags = (unsigned*)(ws + WS_FLAGS); unsigned* rec = (unsigned*)(ws + WS_X1);
        for (int round = 1; round <= 40; ++round) {
            const int slot = (bx + round * 37) % G; for (int i = tid; i < 1024; i += NTHR) rec[(size_t)slot * 1024 + i] = (unsigned)round * 65536u + (unsigned)slot;
            GSYNC();
            unsigned bad = 0;
            for (int j = tid; j < G * 16; j += NTHR) { const int b2 = j >> 4, i = (j & 15) * 64 + (round & 63); if (rec[(size_t)b2 * 1024 + i] != (unsigned)round * 65536u + (unsigned)b2) bad = 1; }
            if (bad) atomicOr(flags, 8u);
            GSYNC();
        }
    }
#endif
    for (int l = 0; l < DEPTH; ++l) {
        {
            ARGS(); IDS(); pg8::Gemm g{XN_, (const bf16raw*)(WL_ + WO_IN), M, INC, DM}; pg8::StaticOrder S; S.init(M, INC, G, bx);
            pg8::EpiInProj E{HB_, INC, attn_body::C2};
            pg8::gemm_phase<pg8::EpiInProj, pg8::StaticOrder, true, true>(ldsp, g, S, E);
        }
        GSYNC();
#if defined(DBG_CHECKS) && (DBG_CHECKS & 1)
        {
            ARGS(); IDS(); unsigned* flags = (unsigned*)(ws + WS_FLAGS);
            if (gw < 512) { const unsigned h0 = hsh(gw * 2 + 1 + 7919 * l); const int r = h0 % M, c = (gw < 64) ? (gw * 24 + (h0 >> 20) % 24) : hsh(h0) % INC;
                float ref = dot_aw(XN_ + (size_t)r * DM, ap->in[2] + (size_t)l * DM * INC, c, INC, DM, lane);
                if (c >= 768 && c < 1280) ref *= attn_body::C2;
                const float got = bf2f(HB_[(size_t)r * INC + c]);
                flag_if(flags, !(fabsf(got - ref) <= 0.02f + 0.02f * fabsf(ref)), 1u, lane); }
        }
        GSYNC();
#endif
        {
            ARGS(); IDS(); bf16raw* Hb = HB_; const float* qn = ap->in[3] + l * 64; const float* kn = ap->in[4] + l * 64;
            const int sub = lane & 15;
            for (int it4 = gw; it4 < M * 10 / 4; it4 += NGW) {
                const int item = it4 * 4 + (lane >> 4); const int m = item / 10, hh = item % 10;
                const int col = (hh < 8) ? 64 * hh : 512 + 64 * (hh - 8);
                const float* gn = (hh < 8) ? qn : kn;
                bf16raw* p = Hb + (size_t)m * INC + col + 4 * sub;
                const v2u raw = *(const v2u*)p;
                float x0 = bf2f((unsigned short)(raw.x & 0xffffu)), x1 = bf2f((unsigned short)(raw.x >> 16)), x2 = bf2f((unsigned short)(raw.y & 0xffffu)), x3 = bf2f((unsigned short)(raw.y >> 16));
                float ss = (x0 * x0 + x1 * x1) + (x2 * x2 + x3 * x3);
                ss += __shfl_xor(ss, 1); ss += __shfl_xor(ss, 2); ss += __shfl_xor(ss, 4); ss += __shfl_xor(ss, 8);
                const float rinv = rsqrtf(ss * (1.0f / 64.0f) + RMS_EPS);
                const f32x4 gv = *(const f32x4*)(gn + 4 * sub);
                x0 = x0 * rinv * gv[0]; x1 = x1 * rinv * gv[1]; x2 = x2 * rinv * gv[2]; x3 = x3 * rinv * gv[3];
                const int s = m & (SEQ - 1); const float pos = (float)((sub < 8) ? (s >> 6) : (s & 63));
                const int fi0 = (2 * sub) & 15, fi1 = (2 * sub + 1) & 15;
                const float if0 = exp2f(-(float)fi0 * (13.287712379549449f / 16.0f)), if1 = exp2f(-(float)fi1 * (13.287712379549449f / 16.0f));
                float r0 = (pos * if0) * 0.15915494309189535f, r1 = (pos * if1) * 0.15915494309189535f;
                r0 -= floorf(r0); r1 -= floorf(r1);
                const float c0 = __builtin_amdgcn_cosf(r0), s0 = __builtin_amdgcn_sinf(r0), c1 = __builtin_amdgcn_cosf(r1), s1 = __builtin_amdgcn_sinf(r1);
                const float sc = (hh < 8) ? attn_body::C2 : 1.0f;
                const float y0 = (x0 * c0 - x1 * s0) * sc, y1 = (x0 * s0 + x1 * c0) * sc, y2 = (x2 * c1 - x3 * s1) * sc, y3 = (x2 * s1 + x3 * c1) * sc;
                v2u o; o.x = pk2(y0, y1); o.y = pk2(y2, y3);
                *(v2u*)p = o;
            }
        }
        GSYNC();
        {
            ARGS(); IDS(); bf16raw* Hb = HB_; bf16raw* Yb = YB_; float* tblG = TBL_; const float* sink = ap->in[5] + l * 8;
            for (int uid = vcu; uid < 1024; uid += G) {
                const int v = uid & 255, i = uid >> 8, s = v & 7, bh = v >> 3;
                const int qb = (i == 0) ? s : (i == 1) ? 15 - s : (i == 2) ? 16 + s : 31 - s;
                attn_body::attn_unit<8, false>(bh >> 3, bh & 7, qb, (const attn_body::bf16*)Hb, (attn_body::bf16*)Yb, (char*)lds, nullptr, 0.f);
            }
            for (int uid = vcu; uid < 1024; uid += G) {
                const int v = uid & 255, i = uid >> 8, s = v & 7, bh = v >> 3;
                const int qb = (i == 0) ? s : (i == 1) ? 15 - s : (i == 2) ? 16 + s : 31 - s;
                attn_body::attn_unit<8, true>(bh >> 3, bh & 7, qb, (const attn_body::bf16*)Hb, (attn_body::bf16*)Yb, (char*)lds, tblG + (bh & 7) * attn_body::TBLN, sink[bh & 7] * LOG2E);
            }
        }
        GSYNC();
#if defined(DBG_CHECKS) && (DBG_CHECKS & 2)
        {
            ARGS(); IDS(); unsigned* flags = (unsigned*)(ws + WS_FLAGS); const bf16raw* Hb = HB_; const bf16raw* Yb = YB_; const float* tblG = TBL_;
            if (gw < 256) { const unsigned h0 = hsh(gw * 2 + 77 + 131 * l); const int win = gw & 1; const int b = (h0 >> 3) & 3, h = h0 & 7;
                int q = (h0 >> 8) & (SEQ - 1); if ((gw >> 1) % 8 == 0) q = ((h0 >> 8) & 31) * 256 + ((gw & 32) ? 255 : 0); if ((gw >> 1) % 8 == 1) q = (gw & 32) ? SEQ - 1 - ((h0 >> 8) & 127) : ((h0 >> 8) & 127);
                const int QC = win ? 768 : 0, KC = win ? 1280 : 512, VC = win ? 1408 : 640, OC = win ? 512 : 0;
                const bf16raw* qp = Hb + ((size_t)b * SEQ + q) * INC + QC + h * 64;
                const int klo = win ? (q - 128 < 0 ? 0 : q - 128) : 0, khi = win ? (q + 128 > SEQ - 1 ? SEQ - 1 : q + 128) : SEQ - 1;
                float mx = -1e30f;
                for (int k = klo + lane; k <= khi; k += 64) { const bf16raw* kp = Hb + ((size_t)b * SEQ + k) * INC + KC + (h >> 2) * 64; float s = 0.f; for (int d = 0; d < 64; ++d) s += bf2f(qp[d]) * bf2f(kp[d]); if (win) s += tblG[h * attn_body::TBLN + (k - q) + 384]; mx = fmaxf(mx, s); }
#pragma unroll
                for (int o = 1; o < 64; o <<= 1) mx = fmaxf(mx, __shfl_xor(mx, o));
                float den = 0.f, o0 = 0.f, o1 = 0.f, o2 = 0.f, o3 = 0.f;
                for (int k = klo + lane; k <= khi; k += 64) { const bf16raw* kp = Hb + ((size_t)b * SEQ + k) * INC + KC + (h >> 2) * 64; const bf16raw* vp = Hb + ((size_t)b * SEQ + k) * INC + VC + (h >> 2) * 64; float s = 0.f; for (int d = 0; d < 64; ++d) s += bf2f(qp[d]) * bf2f(kp[d]); if (win) s += tblG[h * attn_body::TBLN + (k - q) + 384];
                    const float p = exp2f(s - mx); den += p; o0 += p * bf2f(vp[0]); o1 += p * bf2f(vp[17]); o2 += p * bf2f(vp[42]); o3 += p * bf2f(vp[63]); }
                den = wave_sum(den); o0 = wave_sum(o0); o1 = wave_sum(o1); o2 = wave_sum(o2); o3 = wave_sum(o3);
                if (win) den += exp2f(ap->in[5][l * 8 + h] * LOG2E - mx);
                const bf16raw* yp = Yb + ((size_t)b * SEQ + q) * DM + OC + h * 64;
                const float e0 = fabsf(bf2f(yp[0]) - o0 / den), e1 = fabsf(bf2f(yp[17]) - o1 / den), e2 = fabsf(bf2f(yp[42]) - o2 / den), e3 = fabsf(bf2f(yp[63]) - o3 / den);
                const float em = fmaxf(fmaxf(e0, e1), fmaxf(e2, e3));
                flag_if(flags, !(em <= 0.02f), win ? 4u : 2u, lane); }
        }
        GSYNC();
#endif
        {
            ARGS(); IDS(); bf16raw* Yb = YB_; const float* ga = ap->in[6] + l * 512; const float* gb = ap->in[7] + l * 512;
            f32x4 gA0 = *(const f32x4*)(ga + 8 * lane), gA1 = *(const f32x4*)(ga + 8 * lane + 4), gB0 = *(const f32x4*)(gb + 8 * lane), gB1 = *(const f32x4*)(gb + 8 * lane + 4);
            for (int m = gw; m < M; m += NGW) {
                bf16raw* pa = Yb + (size_t)m * DM + 8 * lane; bf16raw* pb = pa + 512;
                const v4u ra = *(const v4u*)pa, rb = *(const v4u*)pb;
                float va[8], vb[8];
#pragma unroll
                for (int j = 0; j < 4; ++j) { va[2 * j] = bf2f((unsigned short)(ra[j] & 0xffffu)); va[2 * j + 1] = bf2f((unsigned short)(ra[j] >> 16)); vb[2 * j] = bf2f((unsigned short)(rb[j] & 0xffffu)); vb[2 * j + 1] = bf2f((unsigned short)(rb[j] >> 16)); }
                float sa = 0.f, sb = 0.f;
#pragma unroll
                for (int j = 0; j < 8; ++j) { sa += va[j] * va[j]; sb += vb[j] * vb[j]; }
                sa = wave_sum(sa); sb = wave_sum(sb);
#ifdef ZERO_A
                for (int j = 0; j < 8; ++j) va[j] = 0.f;
#endif
#ifdef ZERO_B
                for (int j = 0; j < 8; ++j) vb[j] = 0.f;
#endif
                const float rA = rsqrtf(sa * (1.0f / 512.0f) + RMS_EPS), rB = rsqrtf(sb * (1.0f / 512.0f) + RMS_EPS);
                v4u oa, ob;
                oa.x = pk2(va[0] * rA * gA0[0], va[1] * rA * gA0[1]); oa.y = pk2(va[2] * rA * gA0[2], va[3] * rA * gA0[3]); oa.z = pk2(va[4] * rA * gA1[0], va[5] * rA * gA1[1]); oa.w = pk2(va[6] * rA * gA1[2], va[7] * rA * gA1[3]);
                ob.x = pk2(vb[0] * rB * gB0[0], vb[1] * rB * gB0[1]); ob.y = pk2(vb[2] * rB * gB0[2], vb[3] * rB * gB0[3]); ob.z = pk2(vb[4] * rB * gB1[0], vb[5] * rB * gB1[1]); ob.w = pk2(vb[6] * rB * gB1[2], vb[7] * rB * gB1[3]);
                *(v4u*)pa = oa; *(v4u*)pb = ob;
            }
        }
        GSYNC();
        {
            ARGS(); IDS(); const float* xres = (l == 0) ? ap->in[0] : ap->out;
            pg8::Gemm g{YB_, (const bf16raw*)(WL_ + WO_OUT), M, DM, DM}; pg8::StaticOrder S; S.init(M, DM, G, bx);
            pg8::EpiRes E{xres, ap->out, DM, ALPHA, 1.0f};
            pg8::gemm_phase<pg8::EpiRes, pg8::StaticOrder, true, true>(ldsp, g, S, E);
        }
        GSYNC();
#if defined(DBG_CHECKS) && (DBG_CHECKS & 4)
        {
            ARGS(); IDS(); unsigned* flags = (unsigned*)(ws + WS_FLAGS); const float* xres = (l == 0) ? ap->in[0] : ap->out;
            if (gw < 512) { const unsigned h0 = hsh(gw * 2 + 3 + 104729 * l); const int r = h0 % M, c = hsh(h0) % DM;
                const float ref = ALPHA * xres[(size_t)r * DM + c] + dot_aw(YB_ + (size_t)r * DM, ap->in[8] + (size_t)l * DM * DM, c, DM, DM, lane);
                const float got = ap->out[(size_t)r * DM + c];
                flag_if(flags, l == 0 && !(fabsf(got - ref) <= 0.02f + 0.01f * fabsf(ref)), 8u, lane); }
        }
        GSYNC();
#endif
        { ARGS(); IDS(); ln_rows(ap->out, X1_, XN_, ap->in[9] + l * DM, ap->in[10] + l * DM, gw, NGW, lane); }
        GSYNC();
#if defined(DBG_CHECKS) && (DBG_CHECKS & 256)
        {
            ARGS(); IDS(); unsigned* flags = (unsigned*)(ws + WS_FLAGS);
            if (gw < 2048) { const unsigned h0 = hsh(gw * 2 + 13 + 67867967 * l); const int r = h0 % M; const float* z = ap->out + (size_t)r * DM;
                float sm = 0.f; for (int c = lane; c < DM; c += 64) sm += z[c]; sm = wave_sum(sm) * (1.f / DM);
                float sv = 0.f; for (int c = lane; c < DM; c += 64) { const float d = z[c] - sm; sv += d * d; } sv = wave_sum(sv) * (1.f / DM);
                const float rs = rsqrtf(sv + LN_EPS); float b1 = 0.f, b2 = 0.f;
                for (int c = lane; c < DM; c += 64) { const float y = (z[c] - sm) * rs * ap->in[9][l * DM + c] + ap->in[10][l * DM + c];
                    if (!(fabsf(X1_[(size_t)r * DM + c] - y) <= 0.002f + 0.002f * fabsf(y))) b1 = 1.f;
                    if (!(fabsf(bf2f(XN_[(size_t)r * DM + c]) - y) <= 0.01f + 0.01f * fabsf(y))) b2 = 1.f; }
                b1 = wave_sum(b1); b2 = wave_sum(b2);
                if (b1 > 0.f && lane == 0) atomicAdd(flags + 1, 1u); if (b2 > 0.f && lane == 0) atomicAdd(flags + 2, 1u); }
        }
        GSYNC();
#endif
#if defined(DBG_CHECKS) && (DBG_CHECKS & 64)
        {
            ARGS(); IDS(); unsigned* flags = (unsigned*)(ws + WS_FLAGS);
            if (gw < 2048) { const unsigned h0 = hsh(gw * 2 + 11 + 49979687 * l + 0); const int r = h0 % M; float bad = 0.f;
                for (int c = lane; c < DM; c += 64) { const float a = X1_[(size_t)r * DM + c], b = bf2f(XN_[(size_t)r * DM + c]); if (!(fabsf(a - b) <= 0.01f + 0.01f * fabsf(a))) bad = 1.f; }
                bad = wave_sum(bad); if (bad > 0.f && lane == 0) atomicAdd(flags + 1, 1u); if (bad > 512.f && lane == 0) atomicAdd(flags + 2, 1u); }
        }
        GSYNC();
#endif
        {
            ARGS(); IDS(); pg8::Gemm g{XN_, (const bf16raw*)(WL_ + WO_GU), M, NGU, DM}; pg8::StaticOrder S; S.init(M, NGU, G, bx);
            pg8::EpiConvGlu E{HH_, ap->in[13] + (size_t)l * 3 * FF, ap->in[14] + (size_t)l * FF, SIDE_};
            pg8::gemm_phase<pg8::EpiConvGlu, pg8::StaticOrder, true, true>(ldsp, g, S, E);
        }
        GSYNC();
#if defined(DBG_CHECKS) && (DBG_CHECKS & 64)
        {
            ARGS(); IDS(); unsigned* flags = (unsigned*)(ws + WS_FLAGS);
            if (gw < 2048) { const unsigned h0 = hsh(gw * 2 + 11 + 49979687 * l + 1); const int r = h0 % M; float bad = 0.f;
                for (int c = lane; c < DM; c += 64) { const float a = X1_[(size_t)r * DM + c], b = bf2f(XN_[(size_t)r * DM + c]); if (!(fabsf(a - b) <= 0.01f + 0.01f * fabsf(a))) bad = 1.f; }
                bad = wave_sum(bad); if (bad > 0.f && lane == 0) atomicAdd(flags + 1, 1u); if (bad > 512.f && lane == 0) atomicAdd(flags + 2, 1u); }
        }
        GSYNC();
#endif
        {
            ARGS(); IDS(); float* side = SIDE_; bf16raw* HH = HH_; const float* cw = ap->in[13] + (size_t)l * 3 * FF;
            for (int it = gt; it < 512 * 2 * (FF / 4); it += NGT) {
                const int f = 4 * (it % (FF / 4)), ct = it / (FF / 4), tb = ct & 1, c = ct >> 1;
                const int r = 64 * c + (tb ? 63 : 0), s = r & (SEQ - 1);
                f32x4 gc = *(const f32x4*)(side + ((size_t)ct * 3 + 0) * FF + f); const f32x4 uu = *(const f32x4*)(side + ((size_t)ct * 3 + 1) * FF + f);
                if (!tb && s != 0) { const f32x4 gn = *(const f32x4*)(side + ((size_t)((c - 1) * 2 + 1) * 3 + 2) * FF + f); gc += *(const f32x4*)(cw + f) * gn; }
                if (tb && s != SEQ - 1) { const f32x4 gn = *(const f32x4*)(side + ((size_t)((c + 1) * 2 + 0) * 3 + 2) * FF + f); gc += *(const f32x4*)(cw + 2 * FF + f) * gn; }
                v2u o; o.x = pk2(pg8::gelu_tanh(gc[0]) * uu[0], pg8::gelu_tanh(gc[1]) * uu[1]); o.y = pk2(pg8::gelu_tanh(gc[2]) * uu[2], pg8::gelu_tanh(gc[3]) * uu[3]);
                *(v2u*)(HH + (size_t)r * FF + f) = o;
            }
        }
        GSYNC();
#if defined(DBG_CHECKS) && (DBG_CHECKS & 8)
        {
            ARGS(); IDS(); unsigned* flags = (unsigned*)(ws + WS_FLAGS);
            if (gw < 512) { const unsigned h0 = hsh(gw * 2 + 5 + 15485863 * l); const int f = hsh(h0) % FF; int r = h0 % M;
                const int kind = gw & 7; if (kind == 0) r = (r & ~63); if (kind == 1) r = (r & ~63) + 63; if (kind == 2) r = (r & ~255); if (kind == 3) r = (r & ~255) + 255; if (kind == 4) r = (r & ~(SEQ - 1)); if (kind == 5) r = (r & ~(SEQ - 1)) + SEQ - 1;
                const int s = r & (SEQ - 1);
                const float* wg = ap->in[11] + (size_t)l * DM * FF; const float* wu = ap->in[12] + (size_t)l * DM * FF; const float* cw = ap->in[13] + (size_t)l * 3 * FF;
                float gc = ap->in[14][(size_t)l * FF + f];
                if (s > 0) gc += cw[f] * dot_aw(XN_ + (size_t)(r - 1) * DM, wg, f, FF, DM, lane);
                gc += cw[FF + f] * dot_aw(XN_ + (size_t)r * DM, wg, f, FF, DM, lane);
                if (s < SEQ - 1) gc += cw[2 * FF + f] * dot_aw(XN_ + (size_t)(r + 1) * DM, wg, f, FF, DM, lane);
                const float u = dot_aw(XN_ + (size_t)r * DM, wu, f, FF, DM, lane);
                const float yy = 0.7978845608f * (gc + 0.044715f * gc * gc * gc); const float th = 1.0f - 2.0f / (1.0f + __expf(2.0f * yy)); const float ref = 0.5f * gc * (1.0f + th) * u;
                const float got = bf2f(HH_[(size_t)r * FF + f]);
                flag_if(flags, !(fabsf(got - ref) <= 0.03f + 0.03f * fabsf(ref)), 16u, lane); }
        }
        GSYNC();
#endif
#if defined(DBG_CHECKS) && (DBG_CHECKS & 64)
        {
            ARGS(); IDS(); unsigned* flags = (unsigned*)(ws + WS_FLAGS);
            if (gw < 2048) { const unsigned h0 = hsh(gw * 2 + 11 + 49979687 * l + 2); const int r = h0 % M; float bad = 0.f;
                for (int c = lane; c < DM; c += 64) { const float a = X1_[(size_t)r * DM + c], b = bf2f(XN_[(size_t)r * DM + c]); if (!(fabsf(a - b) <= 0.01f + 0.01f * fabsf(a))) bad = 1.f; }
                bad = wave_sum(bad); if (bad > 0.f && lane == 0) atomicAdd(flags + 1, 1u); if (bad > 512.f && lane == 0) atomicAdd(flags + 2, 1u); }
        }
        GSYNC();
#endif
        {
            ARGS(); IDS(); pg8::Gemm g{HH_, (const bf16raw*)(WL_ + WO_DN), M, DM, FF}; pg8::StaticOrder S; S.init(M, DM, G, bx);
            pg8::EpiRes E{X1_, ap->out, DM, ALPHA, FFN_SCALE};
            pg8::gemm_phase<pg8::EpiRes, pg8::StaticOrder, true, true>(ldsp, g, S, E);
        }
        GSYNC();
#if defined(DBG_CHECKS) && (DBG_CHECKS & 16)
        {
            ARGS(); IDS(); unsigned* flags = (unsigned*)(ws + WS_FLAGS);
            if (gw < 512) { const unsigned h0 = hsh(gw * 2 + 9 + 32452843 * l); const int r = h0 % M, c = hsh(h0) % DM;
                const float ref = ALPHA * X1_[(size_t)r * DM + c] + dot_aw(HH_ + (size_t)r * FF, ap->in[15] + (size_t)l * FF * DM, c, DM, FF, lane);
                const float got = ap->out[(size_t)r * DM + c];
                if (!(fabsf(got - ref) <= 0.02f + 0.005f * fabsf(ref)) && lane == 0) atomicAdd(flags + 1, 1u); if (!(fabsf(got - ref) <= 0.3f) && lane == 0) atomicAdd(flags + 2, 1u); }
        }
        GSYNC();
#endif
        { ARGS(); IDS(); ln_rows(ap->out, ap->out, XN_, ap->in[16] + l * DM, ap->in[17] + l * DM, gw, NGW, lane); }
        if (l + 1 < DEPTH) GSYNC();
    }
#ifdef DBG_CHECKS
    GSYNC();
    { ARGS(); IDS(); if (gt == 0) { unsigned fl = __hip_atomic_load((unsigned*)(ws + WS_FLAGS), __ATOMIC_RELAXED, __HIP_MEMORY_SCOPE_AGENT); const unsigned cn = __hip_atomic_load((unsigned*)(ws + WS_FLAGS) + 1, __ATOMIC_RELAXED, __HIP_MEMORY_SCOPE_AGENT); if (cn >= 1) fl |= 32u; if (cn >= 16) fl |= 64u; if (cn >= 256) fl |= 128u; if (cn >= 900) fl |= 256u; { const unsigned c2 = __hip_atomic_load((unsigned*)(ws + WS_FLAGS) + 2, __ATOMIC_RELAXED, __HIP_MEMORY_SCOPE_AGENT); if (c2 >= 1) fl |= 512u; if (c2 >= 256) fl |= 1024u; } if (fl) ap->out[0] = 1.0e4f * (float)(1u + fl); } }
#endif
}

extern "C" void kernel_launch(void* const* d_in, const int* in_sizes, int n_in, void* d_out, int out_size, void* d_ws, size_t ws_size, hipStream_t stream) {
    static int grid = 0;
    if (grid == 0) {
        if (n_in != 18 || in_sizes[0] != M * DM || out_size != M * DM || ws_size < WS_END) { fprintf(stderr, "kernel_launch: unexpected shapes (n_in %d, in0 %d, out %d, ws %zu < %zu); nothing launched\n", n_in, n_in > 0 ? in_sizes[0] : -1, out_size, ws_size, (size_t)WS_END); grid = -1; return; }
        int dev = 0, cus = 0, per_cu = 0;
        if (hipGetDevice(&dev) != hipSuccess || hipDeviceGetAttribute(&cus, hipDeviceAttributeMultiprocessorCount, dev) != hipSuccess) { fprintf(stderr, "kernel_launch: device query failed\n"); grid = -1; return; }
        if (hipFuncSetAttribute((const void*)fwd_kernel, hipFuncAttributeMaxDynamicSharedMemorySize, LDS_BYTES) != hipSuccess) { fprintf(stderr, "kernel_launch: hipFuncSetAttribute failed\n"); grid = -1; return; }
        if (hipOccupancyMaxActiveBlocksPerMultiprocessor(&per_cu, (const void*)fwd_kernel, NTHR, LDS_BYTES) != hipSuccess || per_cu < 1) { fprintf(stderr, "kernel_launch: occupancy query says %d blocks per CU\n", per_cu); per_cu = 1; }
        (void)hipGetLastError();
        grid = cus * per_cu;
    }
    if (grid < 0) return;
    Args a{};
    for (int i = 0; i < 18; ++i) a.in[i] = (const float*)d_in[i];
    a.out = (float*)d_out; a.ws = (unsigned char*)d_ws;
    void* args[] = {&a};
    hipError_t e = hipLaunchCooperativeKernel((const void*)fwd_kernel, dim3(grid), dim3(NTHR), args, LDS_BYTES, stream);
    if (e != hipSuccess) fprintf(stderr, "kernel_launch: cooperative launch failed: %s (grid %d)\n", hipGetErrorString(e), grid);
}
```

```cpp
#include <hip/hip_runtime.h>
#include <hip/hip_cooperative_groups.h>
#include <hip/hip_bf16.h>
#include <cstdio>
#include <cstdint>
#include <cmath>
namespace cg = cooperative_groups;
#ifndef FFN_SCALE
#define FFN_SCALE 1.0f
#endif
namespace pg8 {
#define PG8_LAS __attribute__((address_space(3)))
typedef unsigned short bf16_t;
typedef short bf16x8 __attribute__((ext_vector_type(8)));
typedef float f32x4 __attribute__((ext_vector_type(4)));
typedef unsigned u32x4 __attribute__((ext_vector_type(4)));
constexpr int BM = 256, BK = 64, HALF = 128, HTB = HALF * BK * 2  , STAGE_BYTES = 8 * HTB, NXCD = 8, WGM = 8;

__host__ __device__ __forceinline__ int lds_byte(int r, int c) { const int st = (r >> 4) * 2 + (c >> 5), rr = r & 15, cc = c & 31, ob = rr * 64 + cc * 2; return st * 1024 + (ob ^ (((ob >> 9) & 1) << 5)); }
__host__ __device__ __forceinline__ void stage_rc(int b, int& R, int& C) { const int st = b / 1024, sb = b % 1024, swz = sb ^ (((sb >> 9) & 1) << 5); R = (st >> 1) * 16 + swz / 64; C = (st & 1) * 32 + (swz % 64) / 2; }
__host__ __device__ __forceinline__ int perm32(int rho) { const int n = rho >> 4, i = rho & 15; return 8 * (i >> 2) + 4 * n + (i & 3); }

struct Unit { int pm, pn; };
struct Gemm { const bf16_t* A; const bf16_t* Bt; int M, N, K; };

struct StaticOrder {
    int nM, nN, nwg, G, c;
    __host__ __device__ void init(int M, int N, int G_, int c_) { nM = M / BM; nN = N / BM; nwg = nM * nN; G = G_; c = c_; }
    __host__ __device__ bool next(int i, Unit& u) const {
        const long L = (long)i * G + c; if (L >= nwg) return false;
        int wgid = (int)L; { const int q = nwg / NXCD, r = nwg % NXCD, xcd = wgid % NXCD, off = wgid / NXCD; wgid = (xcd < r ? xcd * (q + 1) : r * (q + 1) + (xcd - r) * q) + off; }
        const int nig = WGM * nN, gid = wgid / nig, fm = gid * WGM, gsz = (nM - fm) < WGM ? (nM - fm) : WGM;
        u.pm = fm + ((wgid % nig) % gsz); u.pn = (wgid % nig) / gsz; return true;
    }
    __device__ __forceinline__ void a_ready(const Unit&) const {}
    __device__ __forceinline__ void done(const Unit&) const {}
};

__device__ __forceinline__ unsigned cvt_pk_bf16(float lo, float hi) { unsigned r; asm volatile("v_cvt_pk_bf16_f32 %0, %1, %2" : "=v"(r) : "v"(lo), "v"(hi)); return r; }
typedef float f32x2 __attribute__((ext_vector_type(2)));
__device__ __forceinline__ float gelu_tanh(float x) {
    const float y = 0.7978845608028654f * (x + 0.044715f * x * x * x);
    const float e = __builtin_amdgcn_exp2f(-2.8853900817779268f * y);
    return x * __builtin_amdgcn_rcpf(1.0f + e);
}
struct EpiInProj {
    static constexpr bool PERM = true, AFTER_DRAIN = false;
    bf16_t* O; int ldc; float qscale;
    __device__ __forceinline__ void operator()(const f32x4 (&acc)[2][2][4][2], const Unit& u, int wr, int wc, int fr, int fq) const {
        const int row0 = u.pm * BM + wr * 64 + fr; const int col0 = u.pn * BM + wc * 32 + 8 * fq;
        const float sc = (u.pn == 3 || u.pn == 4) ? qscale : 1.f;
#pragma unroll
        for (int ai = 0; ai < 2; ++ai)
#pragma unroll
            for (int m = 0; m < 4; ++m) { bf16_t* rowp = O + (size_t)(row0 + ai * HALF + m * 16) * ldc + col0;
#pragma unroll
                for (int bj = 0; bj < 2; ++bj) { const f32x4 v0 = acc[ai][bj][m][0] * sc, v1 = acc[ai][bj][m][1] * sc;
                    u32x4 w; w.x = cvt_pk_bf16(v0[0], v0[1]); w.y = cvt_pk_bf16(v0[2], v0[3]); w.z = cvt_pk_bf16(v1[0], v1[1]); w.w = cvt_pk_bf16(v1[2], v1[3]);
                    *(u32x4*)(rowp + bj * HALF) = w; } }
    }
};
struct EpiRes {
    static constexpr bool PERM = false, AFTER_DRAIN = false;
    const float* res; float* out; int ldc; float alpha, accs;
    __device__ __forceinline__ void operator()(const f32x4 (&acc)[2][2][4][2], const Unit& u, int wr, int wc, int fr, int fq) const {
        const int col0 = u.pn * BM + wc * 32 + 4 * fq;
#pragma unroll
        for (int ai = 0; ai < 2; ++ai)
#pragma unroll
            for (int m = 0; m < 4; ++m) { const size_t off = (size_t)(u.pm * BM + ai * HALF + wr * 64 + m * 16 + fr) * ldc + col0;
                f32x4 bs[2][2];
#pragma unroll
                for (int bj = 0; bj < 2; ++bj)
#pragma unroll
                    for (int n = 0; n < 2; ++n) bs[bj][n] = *(const f32x4*)(res + off + bj * HALF + n * 16);
#pragma unroll
                for (int bj = 0; bj < 2; ++bj)
#pragma unroll
                    for (int n = 0; n < 2; ++n) { const f32x4 o = bs[bj][n] * alpha + acc[ai][bj][m][n] * accs; *(f32x4*)(out + off + bj * HALF + n * 16) = o; }
                asm volatile("" ::: "memory"); }
    }
};
constexpr int FFD = 2816;
struct EpiConvGlu {
    static constexpr bool PERM = true, AFTER_DRAIN = false;
    bf16_t* HH; const float* cw; const float* cb; float* side;
    __device__ __forceinline__ void operator()(const f32x4 (&acc)[2][2][4][2], const Unit& u, int wr, int wc, int fr, int fq) const {
        const int lane = threadIdx.x & 63;
        const int f0 = u.pn * 128 + wc * 32 + 8 * fq;
        const int ldn = (lane & 48) | ((lane + 15) & 15);
        const int lup = (lane & 48) | ((lane + 1) & 15);
        f32x4 W0[2], W1[2], W2[2], BB[2];
#pragma unroll
        for (int n = 0; n < 2; ++n) { W0[n] = *(const f32x4*)(cw + f0 + 4 * n); W1[n] = *(const f32x4*)(cw + FFD + f0 + 4 * n); W2[n] = *(const f32x4*)(cw + 2 * FFD + f0 + 4 * n); BB[n] = *(const f32x4*)(cb + f0 + 4 * n); }
#pragma unroll
        for (int ai = 0; ai < 2; ++ai) {
            const int chunk = u.pm * 4 + ai * 2 + wr; const int rbase = chunk * 64;
            f32x4 RdP[2], RuC[2];
#pragma unroll
            for (int n = 0; n < 2; ++n) { RdP[n] = (f32x4){0.f, 0.f, 0.f, 0.f};
#pragma unroll
                for (int e = 0; e < 4; ++e) RuC[n][e] = __shfl(acc[ai][0][0][n][e], lup); }
#pragma unroll
            for (int m = 0; m < 4; ++m) {
                f32x4 RdC[2], RuN[2], hv[2];
#pragma unroll
                for (int n = 0; n < 2; ++n) {
#pragma unroll
                    for (int e = 0; e < 4; ++e) { RdC[n][e] = __shfl(acc[ai][0][m][n][e], ldn); RuN[n][e] = (m < 3) ? __shfl(acc[ai][0][m < 3 ? m + 1 : 3][n][e], lup) : 0.f; }
                }
                const bool top = (m == 0) && (fr == 0), bot = (m == 3) && (fr == 15);
                float* sp = side + ((size_t)(chunk * 2 + (bot ? 1 : 0)) * 3) * FFD + f0;
#pragma unroll
                for (int n = 0; n < 2; ++n) {
                    const f32x4 g = acc[ai][0][m][n], uu = acc[ai][1][m][n];
                    f32x4 prev, next;
#pragma unroll
                    for (int e = 0; e < 4; ++e) { prev[e] = (fr > 0) ? RdC[n][e] : RdP[n][e]; next[e] = (fr < 15) ? RuC[n][e] : RuN[n][e]; }
                    const f32x4 gc = BB[n] + W0[n] * prev + W1[n] * g + W2[n] * next;
#pragma unroll
                    for (int e = 0; e < 4; ++e) hv[n][e] = gelu_tanh(gc[e]) * uu[e];
                    if (top || bot) { *(f32x4*)(sp + 4 * n) = gc; *(f32x4*)(sp + FFD + 4 * n) = uu; *(f32x4*)(sp + 2 * FFD + 4 * n) = g; }
                }
                u32x4 w; w.x = cvt_pk_bf16(hv[0][0], hv[0][1]); w.y = cvt_pk_bf16(hv[0][2], hv[0][3]); w.z = cvt_pk_bf16(hv[1][0], hv[1][1]); w.w = cvt_pk_bf16(hv[1][2], hv[1][3]);
                *(u32x4*)(HH + (size_t)(rbase + m * 16 + fr) * FFD + f0) = w;
#pragma unroll
                for (int n = 0; n < 2; ++n) { RdP[n] = RdC[n]; RuC[n] = RuN[n]; }
            }
        }
    }
};
template <class Epi, class Sched, bool ALIGN_EPI = false, bool SP2 = false>
__device__ __forceinline__ void gemm_phase(PG8_LAS unsigned char* lds, const Gemm g, const Sched& S, const Epi& E) {
    int tid_ = threadIdx.x; asm volatile("" : "+v"(tid_));
    const int tid = tid_, wid = __builtin_amdgcn_readfirstlane(tid >> 6), lane = tid & 63, wr = wid >> 2, wc = wid & 3, fr = lane & 15, fq = lane >> 4;
    const int K = g.K, nt = K / BK;
    unsigned voffA[2], voffB[2];
#pragma unroll
    for (int i = 0; i < 2; ++i) { int R, C; stage_rc(tid * 16 + i * 8192, R, C); const int Rb = Epi::PERM ? ((R & ~31) + perm32(R & 31)) : R;
        voffA[i] = (unsigned)(R * K + C) * 2u; voffB[i] = (unsigned)(Rb * K + C) * 2u; }
    const size_t kstep = (size_t)(BK * 2);
    const size_t hstep = (size_t)HALF * K * 2;
    const size_t tstep = 2 * hstep;
    const unsigned ldsw = (unsigned)wid * 1024u;
    const int aoff = lds_byte(wr * 64 + fr, fq * 8), boff = lds_byte(wc * 32 + fr, fq * 8);
#define PG8_SA(b, h) (((b) * 2 + (h)) * HTB)
#define PG8_SB(b, h) ((4 + (b) * 2 + (h)) * HTB)
#define PG8_STAGE(bufoff, gbase, voff) do { _Pragma("unroll") for (int _i = 0; _i < 2; ++_i) \
        __builtin_amdgcn_global_load_lds((const unsigned*)((const char*)(gbase) + (voff)[_i]), (PG8_LAS unsigned*)(lds + (bufoff) + ldsw + _i * 8192), 16, 0, 0); } while (0)
#define PG8_LDA(dst, b, h) do { _Pragma("unroll") for (int m = 0; m < 4; ++m) _Pragma("unroll") for (int k = 0; k < 2; ++k) dst[m][k] = *(const PG8_LAS bf16x8*)(lds + PG8_SA(b, h) + aoff + m * 2048 + k * 1024); } while (0)
#define PG8_LDB(dst, b, h) do { _Pragma("unroll") for (int n = 0; n < 2; ++n) _Pragma("unroll") for (int k = 0; k < 2; ++k) dst[n][k] = *(const PG8_LAS bf16x8*)(lds + PG8_SB(b, h) + boff + n * 2048 + k * 1024); } while (0)
#define PG8_MMA(ai, bj, At, Bt) do { __builtin_amdgcn_s_setprio(1); _Pragma("unroll") for (int m = 0; m < 4; ++m) _Pragma("unroll") for (int n = 0; n < 2; ++n) _Pragma("unroll") for (int k = 0; k < 2; ++k) \
        acc[ai][bj][m][n] = __builtin_amdgcn_mfma_f32_16x16x32_bf16(Bt[n][k], At[m][k], acc[ai][bj][m][n], 0, 0, 0); __builtin_amdgcn_s_setprio(0); } while (0)
#define PG8_WAIT_V(n) asm volatile("s_waitcnt vmcnt(" #n ")" ::: "memory")
#define PG8_WAIT_L(n) asm volatile("s_waitcnt lgkmcnt(" #n ")" ::: "memory")
#define PG8_BAR __builtin_amdgcn_s_barrier()
#define PG8_SCHED __builtin_amdgcn_sched_barrier(0)
    Unit cur, nxt; int ui = 0;
    if (!S.next(0, cur)) return;
    f32x4 acc[2][2][4][2];
#pragma unroll
    for (int a = 0; a < 2; ++a)
#pragma unroll
        for (int b = 0; b < 2; ++b)
#pragma unroll
            for (int m = 0; m < 4; ++m)
#pragma unroll
                for (int n = 0; n < 2; ++n) acc[a][b][m][n] = (f32x4){0.f, 0.f, 0.f, 0.f};
    bf16x8 At[4][2], B0[2][2], B1[2][2];
    const char* cA = (const char*)g.A + (size_t)cur.pm * tstep; const char* cB = (const char*)g.Bt + (size_t)cur.pn * tstep;
    S.a_ready(cur);
    if constexpr (SP2) {
        PG8_STAGE(PG8_SB(0, 0), cB, voffB); PG8_STAGE(PG8_SB(0, 1), cB + hstep, voffB); PG8_STAGE(PG8_SA(0, 0), cA, voffA); PG8_STAGE(PG8_SA(0, 1), cA + hstep, voffA);
        if (wr == 1) PG8_BAR;
        PG8_WAIT_V(2); PG8_BAR;
        PG8_STAGE(PG8_SB(1, 0), cB + kstep, voffB); PG8_STAGE(PG8_SA(1, 0), cA + kstep, voffA); PG8_STAGE(PG8_SB(1, 1), cB + hstep + kstep, voffB);
        PG8_WAIT_V(6); PG8_BAR;
    } else {
        PG8_STAGE(PG8_SB(0, 0), cB, voffB); PG8_STAGE(PG8_SA(0, 0), cA, voffA); PG8_STAGE(PG8_SB(0, 1), cB + hstep, voffB); PG8_STAGE(PG8_SA(0, 1), cA + hstep, voffA);
        if (wr == 1) PG8_BAR;
        PG8_WAIT_V(4); PG8_BAR;
        PG8_STAGE(PG8_SB(1, 0), cB + kstep, voffB); PG8_STAGE(PG8_SA(1, 0), cA + kstep, voffA); PG8_STAGE(PG8_SB(1, 1), cB + hstep + kstep, voffB);
        PG8_WAIT_V(6); PG8_BAR;
    }
    for (;;) {
        const bool has_next = S.next(ui + 1, nxt);
        const char* nA = has_next ? (const char*)g.A + (size_t)nxt.pm * tstep : cA; const char* nB = has_next ? (const char*)g.Bt + (size_t)nxt.pn * tstep : cB;
        for (int t = 0; t < nt; t += 2) {
            const bool last = (t == nt - 2);
            const char* a1 = cA + (size_t)(t + 1) * kstep;
            const char* a2 = last ? nA : cA + (size_t)(t + 2) * kstep; const char* b2 = last ? nB : cB + (size_t)(t + 2) * kstep;
            const char* a3 = a2 + kstep; const char* b3 = b2 + kstep;
            if (last && has_next) S.a_ready(nxt);
            if constexpr (SP2) {
            PG8_LDB(B0, 0, 0); PG8_LDB(B1, 0, 1); PG8_SCHED; PG8_LDA(At, 0, 0); PG8_STAGE(PG8_SA(1, 1), a1 + hstep, voffA);
            PG8_WAIT_V(8); PG8_WAIT_L(0); PG8_BAR; PG8_MMA(0, 0, At, B0); PG8_MMA(0, 1, At, B1); PG8_BAR; PG8_SCHED;
            PG8_LDA(At, 0, 1); PG8_STAGE(PG8_SB(0, 0), b2, voffB); PG8_STAGE(PG8_SB(0, 1), b2 + hstep, voffB); PG8_STAGE(PG8_SA(0, 0), a2, voffA);
            PG8_WAIT_V(8); PG8_WAIT_L(0); PG8_BAR; PG8_MMA(1, 0, At, B0); PG8_MMA(1, 1, At, B1); PG8_BAR; PG8_SCHED;
            PG8_LDB(B0, 1, 0); PG8_LDB(B1, 1, 1); PG8_SCHED; PG8_LDA(At, 1, 0); PG8_STAGE(PG8_SA(0, 1), a2 + hstep, voffA);
            PG8_WAIT_V(8); PG8_WAIT_L(0); PG8_BAR; PG8_MMA(0, 0, At, B0); PG8_MMA(0, 1, At, B1); PG8_BAR; PG8_SCHED;
            PG8_LDA(At, 1, 1); PG8_STAGE(PG8_SB(1, 0), b3, voffB); PG8_STAGE(PG8_SB(1, 1), b3 + hstep, voffB); PG8_STAGE(PG8_SA(1, 0), a3, voffA);
            PG8_WAIT_V(8); PG8_WAIT_L(0); PG8_BAR; PG8_MMA(1, 0, At, B0); PG8_MMA(1, 1, At, B1); PG8_BAR; PG8_SCHED;
            } else {
            PG8_LDB(B0, 0, 0); PG8_SCHED; PG8_LDA(At, 0, 0); PG8_STAGE(PG8_SA(1, 1), a1 + hstep, voffA);
            PG8_WAIT_L(8); PG8_BAR; PG8_WAIT_L(0); PG8_MMA(0, 0, At, B0); PG8_BAR; PG8_SCHED;
            PG8_LDB(B1, 0, 1); PG8_STAGE(PG8_SB(0, 0), b2, voffB);
            PG8_BAR; PG8_WAIT_L(0); PG8_MMA(0, 1, At, B1); PG8_BAR;
            PG8_LDA(At, 0, 1); PG8_STAGE(PG8_SA(0, 0), a2, voffA);
            PG8_BAR; PG8_WAIT_L(0); PG8_MMA(1, 0, At, B0); PG8_BAR; PG8_SCHED;
            PG8_STAGE(PG8_SB(0, 1), b2 + hstep, voffB);
            PG8_WAIT_V(6); PG8_BAR; PG8_MMA(1, 1, At, B1); PG8_BAR;
            PG8_LDB(B0, 1, 0); PG8_SCHED; PG8_LDA(At, 1, 0); PG8_STAGE(PG8_SA(0, 1), a2 + hstep, voffA);
            PG8_WAIT_L(8); PG8_BAR; PG8_WAIT_L(0); PG8_MMA(0, 0, At, B0); PG8_BAR; PG8_SCHED;
            PG8_LDB(B1, 1, 1); PG8_STAGE(PG8_SB(1, 0), b3, voffB);
            PG8_BAR; PG8_WAIT_L(0); PG8_MMA(0, 1, At, B1); PG8_BAR;
            PG8_LDA(At, 1, 1); PG8_STAGE(PG8_SA(1, 0), a3, voffA);
            PG8_BAR; PG8_WAIT_L(0); PG8_MMA(1, 0, At, B0); PG8_BAR; PG8_SCHED;
            PG8_STAGE(PG8_SB(1, 1), b3 + hstep, voffB);
            PG8_WAIT_V(6); PG8_BAR; PG8_MMA(1, 1, At, B1); PG8_BAR;
            }
        }
        if constexpr (ALIGN_EPI) { if (wr == 0) PG8_BAR; }
        if constexpr (!Epi::AFTER_DRAIN) { E(acc, cur, wr, wc, fr, fq); S.done(cur); }
        if (!has_next) break;
#pragma unroll
        for (int a = 0; a < 2; ++a)
#pragma unroll
            for (int b = 0; b < 2; ++b)
#pragma unroll
                for (int m = 0; m < 4; ++m)
#pragma unroll
                    for (int n = 0; n < 2; ++n) acc[a][b][m][n] = (f32x4){0.f, 0.f, 0.f, 0.f};
        cur = nxt; cA = nA; cB = nB; ++ui;
        if constexpr (ALIGN_EPI) { if (wr == 1) PG8_BAR; }
    }
    PG8_WAIT_V(0);
    if constexpr (!ALIGN_EPI) { if (wr == 0) PG8_BAR; }
    PG8_BAR;
    if constexpr (Epi::AFTER_DRAIN) { E.fused(acc, cur, wr, wc, fr, fq, lds, wid, lane); S.done(cur); }
#undef PG8_SA
#undef PG8_SB
#undef PG8_STAGE
#undef PG8_LDA
#undef PG8_LDB
#undef PG8_MMA
#undef PG8_WAIT_V
#undef PG8_WAIT_L
#undef PG8_BAR
#undef PG8_SCHED
}
}
namespace attn_body {
using bf16=__hip_bfloat16;
using bf16x8=__attribute__((ext_vector_type(8)))short;
using s16x4=__attribute__((ext_vector_type(4)))short;
using f32x16=__attribute__((ext_vector_type(16)))float;
using u32x4=__attribute__((ext_vector_type(4)))unsigned;
constexpr int BATCH=4,SEQ=8192,D=64,QP=1536,OP=1024;
constexpr int NW=8,QBLK=32,QB=QBLK*NW,KVBLK=64,NQB=SEQ/QB;
constexpr int TBLN=768;
__device__ __forceinline__ int crow(int r,int hi){return (r&3)+8*(r>>2)+4*hi;}
#define SBAR() __builtin_amdgcn_sched_barrier(0)
constexpr int NSLOT=3, SLOTB=8192;
constexpr int LDS_K=0, LDS_V=NSLOT*SLOTB, LDS_WS=2*NSLOT*SLOTB, LDS_OST=LDS_WS+NW*64*4, LDS_BYTES=LDS_OST+NW*4096, LDS_TBL=LDS_BYTES;
constexpr float C2=0.125f*1.4426950408889634f;
__device__ __forceinline__ void glds16(const void*gsrc,unsigned lds_dst){unsigned keep;
  asm volatile("s_mov_b32 %0, m0\n\ts_mov_b32 m0, %2\n\ts_nop 0\n\tglobal_load_lds_dwordx4 %1, off\n\ts_mov_b32 m0, %0":"=&s"(keep):"v"(gsrc),"s"(lds_dst):"memory");}
__device__ __forceinline__ float max3f(float a,float b,float c){float r;asm("v_max3_f32 %0, %1, %2, %3":"=v"(r):"v"(a),"v"(b),"v"(c));return r;}
__device__ __forceinline__ float max2f(float a,float b){float r;asm("v_max_f32_e32 %0, %1, %2":"=v"(r):"v"(a),"v"(b));return r;}
__device__ __forceinline__ float fadd_s(float a,float b){float r;asm("v_add_f32_e32 %0, %1, %2":"=v"(r):"v"(a),"v"(b));return r;}
__device__ __forceinline__ float fsub_s(float a,float b){float r;asm("v_sub_f32_e32 %0, %1, %2":"=v"(r):"v"(a),"v"(b));return r;}
typedef float f32x2_t __attribute__((ext_vector_type(2))); typedef __bf16 bf16x2_t __attribute__((ext_vector_type(2)));
__device__ __forceinline__ unsigned cvtpk_s(float lo,float hi){f32x2_t v={lo,hi};bf16x2_t b=__builtin_convertvector(v,bf16x2_t);return __builtin_bit_cast(unsigned,b);}
#define WAIT_BAR(N) asm volatile("s_waitcnt vmcnt(" #N ") lgkmcnt(0)\n\ts_barrier":::"memory")

__device__ __forceinline__ void qkt(f32x16&p0,f32x16&p1,const char*Kslot,const bf16x8*qr,const f32x16&negm,int r32,int hi){
  const char*kb=Kslot+hi*1024+r32*16;
  #pragma unroll
  for(int d0=0;d0<4;++d0){
    const bf16x8 b0=*reinterpret_cast<const bf16x8*>(kb+d0*2048);
    const bf16x8 b1=*reinterpret_cast<const bf16x8*>(kb+d0*2048+512);
    if(d0==0){p0=__builtin_amdgcn_mfma_f32_32x32x16_bf16(b0,qr[0],negm,0,0,0);p1=__builtin_amdgcn_mfma_f32_32x32x16_bf16(b1,qr[0],negm,0,0,0);}
    else{p0=__builtin_amdgcn_mfma_f32_32x32x16_bf16(b0,qr[d0],p0,0,0,0);p1=__builtin_amdgcn_mfma_f32_32x32x16_bf16(b1,qr[d0],p1,0,0,0);}}
}
typedef __attribute__((address_space(3))) const char* lds_cptr;
typedef short v4i16_t __attribute__((ext_vector_type(4)));
__device__ __forceinline__ void kload8(bf16x8*kf,lds_cptr kp){
  kf[0]=*(const __attribute__((address_space(3))) bf16x8*)(kp);      kf[1]=*(const __attribute__((address_space(3))) bf16x8*)(kp+512);
  kf[2]=*(const __attribute__((address_space(3))) bf16x8*)(kp+2048); kf[3]=*(const __attribute__((address_space(3))) bf16x8*)(kp+2560);
  kf[4]=*(const __attribute__((address_space(3))) bf16x8*)(kp+4096); kf[5]=*(const __attribute__((address_space(3))) bf16x8*)(kp+4608);
  kf[6]=*(const __attribute__((address_space(3))) bf16x8*)(kp+6144); kf[7]=*(const __attribute__((address_space(3))) bf16x8*)(kp+6656);
}
__device__ __forceinline__ void kload2(bf16x8*kf,lds_cptr kp,int j){ kf[2*j]=*(const __attribute__((address_space(3))) bf16x8*)(kp+j*2048); kf[2*j+1]=*(const __attribute__((address_space(3))) bf16x8*)(kp+j*2048+512); }
__device__ __forceinline__ s16x4 vtr(lds_cptr p){ return __builtin_bit_cast(s16x4,__builtin_amdgcn_ds_read_tr16_b64_v4i16((__attribute__((address_space(3))) v4i16_t*)p)); }
__device__ __forceinline__ float rowmax(const f32x16&p0,const f32x16&p1){
  float a=max3f(p0[0],p0[1],p1[0]),b=max3f(p0[2],p0[3],p1[1]);a=max3f(a,p1[2],p1[3]);
  #pragma unroll
  for(int r=4;r<16;r+=4){a=max3f(a,p0[r],p0[r+1]);b=max3f(b,p0[r+2],p0[r+3]);a=max3f(a,p1[r],p1[r+1]);b=max3f(b,p1[r+2],p1[r+3]);}
  const float m=max2f(a,b);
  auto rr=__builtin_amdgcn_permlane32_swap(__float_as_uint(m),__float_as_uint(m),false,false);
  return max2f(__uint_as_float(rr[0]),__uint_as_float(rr[1]));
}
__device__ __forceinline__ void pv(f32x16*o,int vb,bf16x8 pa0,bf16x8 pa1,bf16x8 pa2,bf16x8 pa3){
  #pragma unroll
  for(int d0=0;d0<2;++d0){s16x4 lo[4],hi[4];
    #pragma unroll
    for(int ks=0;ks<4;++ks){
      asm volatile("ds_read_b64_tr_b16 %0,%1 offset:%c2":"=&v"(lo[ks]):"v"(vb),"i"(d0*4096+ks*1024):"memory");
      asm volatile("ds_read_b64_tr_b16 %0,%1 offset:%c2":"=&v"(hi[ks]):"v"(vb),"i"(d0*4096+ks*1024+512):"memory");}
    asm volatile("s_waitcnt lgkmcnt(0)":::"memory");SBAR();
    #define PK(k) (bf16x8){lo[k][0],lo[k][1],lo[k][2],lo[k][3],hi[k][0],hi[k][1],hi[k][2],hi[k][3]}
    o[d0]=__builtin_amdgcn_mfma_f32_32x32x16_bf16(pa0,PK(0),o[d0],0,0,0);
    o[d0]=__builtin_amdgcn_mfma_f32_32x32x16_bf16(pa1,PK(1),o[d0],0,0,0);
    o[d0]=__builtin_amdgcn_mfma_f32_32x32x16_bf16(pa2,PK(2),o[d0],0,0,0);
    o[d0]=__builtin_amdgcn_mfma_f32_32x32x16_bf16(pa3,PK(3),o[d0],0,0,0);
    #undef PK
  }
}
#ifndef ATTN_STORE16
#define ATTN_STORE16(p,v) (*(u32x4*)(p)=(v))
#endif
template<int THRL,bool WIN> __device__ __forceinline__ void attn_unit(int b,int h,int qb,const bf16*__restrict__ Hb,bf16*O,char*shm,const float*tblG,float sinkL2){
  int tid_=threadIdx.x; asm volatile("":"+v"(tid_)); const int tid=tid_,lane=tid&63,r32=lane&31,hi=lane>>5; const int wid=__builtin_amdgcn_readfirstlane(tid>>6);
  const long rowbase=(long)b*SEQ; const int q0=qb*QB;
#ifdef DBG_CHECKS
  constexpr bool NONEG=true;
#else
  constexpr bool NONEG=WIN;
#endif
  constexpr int QC=WIN?768:0,KC=WIN?1280:512,VC=WIN?1408:640,OC=WIN?512:0;
  const int tlo=WIN?((qb==0)?2:0):0;
  const long krow0=WIN?(rowbase+q0-128+64*tlo):rowbase;
  const bf16*Qw=Hb+(rowbase+q0+wid*QBLK)*QP+QC+h*D;
  const bf16*Kh=Hb+krow0*QP+KC+(h>>2)*D,*Vh=Hb+krow0*QP+VC+(h>>2)*D;
  const unsigned lds0=(unsigned)(uintptr_t)shm;
  float*wsf=(float*)(shm+LDS_WS)+wid*64;
  const bf16*ksrc=Kh+(long)lane*QP+wid*8;
  const bf16*vsrc=Vh+(long)(16*(wid&3)+(lane>>2))*QP+(wid>>2)*32+(lane&3)*8;
  const unsigned kdst=lds0+LDS_K+wid*1024, vdst=lds0+LDS_V+wid*1024;
  #define DMA_K(t,slot) glds16(ksrc+(long)(t)*KVBLK*QP,(unsigned)__builtin_amdgcn_readfirstlane(kdst+(slot)))
  #define DMA_V(t,slot) glds16(vsrc+(long)(t)*KVBLK*QP,(unsigned)__builtin_amdgcn_readfirstlane(vdst+(slot)))
  const int vb0=(int)(lds0+LDS_V)+((lane>>4)&1)*32+(lane&3)*8+(4*hi+((lane&15)>>2))*64;
  const char*Kbase=shm+LDS_K; bf16x8 kf[8];
  const lds_cptr shm3=(lds_cptr)shm; const lds_cptr kp0=shm3+LDS_K+hi*1024+r32*16; const lds_cptr vp0=shm3+LDS_V+((lane>>4)&1)*32+(lane&3)*8+(4*hi+((lane&15)>>2))*64;
  const int NT=WIN?(8-((qb==0)?2:0)-((qb==NQB-1)?2:0)):(SEQ/KVBLK);
  const __attribute__((address_space(3))) float*tbl=(const __attribute__((address_space(3))) float*)((lds_cptr)shm+LDS_TBL);
  if constexpr(WIN){ for(int i=tid;i<TBLN;i+=NW*64){ const float v_=tblG[i]; ((__attribute__((address_space(3))) float*)((lds_cptr)shm+LDS_TBL))[i]=v_; } asm volatile("s_waitcnt vmcnt(0) lgkmcnt(0)":::"memory"); }
  DMA_K(0,0);DMA_V(0,0);DMA_K(1,SLOTB);
  bf16x8 qr[4];
  #pragma unroll
  for(int d0=0;d0<4;++d0)qr[d0]=*reinterpret_cast<const bf16x8*>(&Qw[(long)r32*QP+d0*16+hi*8]);
  float mhat=0.f,l_reg=0.f;f32x16 o[2];o[0]=f32x16{};o[1]=f32x16{};f32x16 negm=f32x16{}; if constexpr(!NONEG) asm volatile("":"+v"(negm));
  const int qrel=wid*QBLK+r32;
  const int ib=256-qrel+4*hi+64*tlo;
  #define CMASK(P0,P1,t) do{ if constexpr(NONEG&&!WIN){ _Pragma("unroll") for(int r=0;r<16;++r){ P0[r]-=mhat; P1[r]-=mhat; } } if constexpr(WIN){ const __attribute__((address_space(3))) float*tb_=tbl+ib+64*(t); _Pragma("unroll") for(int r=0;r<16;++r){ P0[r]+=tb_[(r&3)+8*(r>>2)]-mhat; P1[r]+=tb_[(r&3)+8*(r>>2)+32]-mhat; } } }while(0)
  bool resc=false;
  #define START(P0,P1) do{ const float rm=rowmax(P0,P1); resc=false; \
    { const float dl=rm; mhat=fadd_s(mhat,dl); \
      _Pragma("unroll") for(int r=0;r<16;++r){P0[r]=fsub_s(P0[r],dl);P1[r]=fsub_s(P1[r],dl);} \
      if constexpr(!NONEG){ _Pragma("unroll") for(int r=0;r<16;++r)negm[r]=-mhat; asm volatile("":"+v"(negm)); } } \
    _Pragma("unroll") for(int r=0;r<16;++r)P0[r]=__builtin_amdgcn_exp2f(P0[r]); }while(0)
  #define RESC() do{ if(resc){ asm volatile("s_waitcnt lgkmcnt(0)":::"memory"); \
      _Pragma("unroll") for(int d_=0;d_<2;++d_) _Pragma("unroll") for(int r=0;r<16;++r)o[d_][r]*=wsf[crow(r,hi)]; } }while(0)
  f32x16 pA0,pA1,pB0,pB1;
  int sl_prev=0,sl_cur=0,sl_next=SLOTB;
  #define ROT() do{sl_prev=sl_cur;sl_cur=sl_next;sl_next=(sl_next==(NSLOT-1)*SLOTB)?0:sl_next+SLOTB;}while(0)
  DMA_K(2,2*SLOTB);
  WAIT_BAR(3);
  qkt(pA0,pA1,Kbase,qr,negm,r32,hi);asm volatile("s_nop 15\n\ts_nop 7":"+v"(pA0),"+v"(pA1));CMASK(pA0,pA1,0);
  START(pA0,pA1);
  _Pragma("unroll") for(int r=0;r<16;++r)pA1[r]=__builtin_amdgcn_exp2f(pA1[r]);
  WAIT_BAR(0);
  DMA_K(3,0);DMA_V(1,SLOTB);
  ROT();
  kload8(kf,kp0+sl_cur);
  WAIT_BAR(2);
  s16x4 vlo[8],vhi[8]; u32x4 pw0,pw1,pw2,pw3;
  #define PKW(P,B) cvtpk_s(P[B],P[B+1])
  #define PAF(k) __builtin_bit_cast(bf16x8,pw##k)
  #define VFR(i) (bf16x8){vlo[i][0],vlo[i][1],vlo[i][2],vlo[i][3],vhi[i][0],vhi[i][1],vhi[i][2],vhi[i][3]}
  #define PIN(x) asm volatile("":"+v"(x))
  #define MX3(a,b,c) __builtin_fmaxf(__builtin_fmaxf((a),(b)),(c))
  #define GAPA(MF,A0,A1,A2,A3,W0,W1,PW) do{ MF; sacc+=A0; sacc+=A1; sacc+=A2; sacc+=A3; PIN(sacc); W0; W1; PIN(PW); SBAR(); }while(0)
  #define EX(v) __builtin_amdgcn_exp2f(v)
  #define GAPB(MF,X,B) do{ MF; X[B]=EX(X[B]); X[B+1]=EX(X[B+1]); X[B+2]=EX(X[B+2]); X[B+3]=EX(X[B+3]); PIN(X); SBAR(); }while(0)
  #define VRD(i) do{ vlo[i]=vtr(vp_+(((i)>>2)*4096+((i)&3)*1024)); vhi[i]=vtr(vp_+(((i)>>2)*4096+((i)&3)*1024+512)); }while(0)
  #define KRD(G,j) do{ if(G){ kload2(kf,kp0+sl_next,j); SBAR(); } }while(0)
  #define STEP(C0,C1,P0,P1,t,GK,GV,GL) do{ SBAR(); \
    const lds_cptr vp_=vp0+sl_prev; \
    VRD(0); SBAR(); float sacc=(P0[0]+P0[1]); \
    GAPA(C0=__builtin_amdgcn_mfma_f32_32x32x16_bf16(kf[0],qr[0],negm,0,0,0), P0[2],P0[3],P0[4],P0[5],     pw0[0]=PKW(P0,0), pw0[1]=PKW(P0,2), pw0); \
    VRD(4); SBAR(); GAPA(C1=__builtin_amdgcn_mfma_f32_32x32x16_bf16(kf[1],qr[0],negm,0,0,0), P0[6],P0[7],P0[8],P0[9],     pw0[2]=PKW(P0,4), pw0[3]=PKW(P0,6), pw0); \
    VRD(1); SBAR(); GAPA(C0=__builtin_amdgcn_mfma_f32_32x32x16_bf16(kf[2],qr[1],C0,0,0,0),   P0[10],P0[11],P0[12],P0[13], pw1[0]=PKW(P0,8), pw1[1]=PKW(P0,10), pw1); \
    VRD(5); SBAR(); GAPA(C1=__builtin_amdgcn_mfma_f32_32x32x16_bf16(kf[3],qr[1],C1,0,0,0),   P0[14],P0[15],P1[0],P1[1],   pw1[2]=PKW(P0,12),pw1[3]=PKW(P0,14), pw1); \
    VRD(2); SBAR(); GAPA(C0=__builtin_amdgcn_mfma_f32_32x32x16_bf16(kf[4],qr[2],C0,0,0,0),   P1[2],P1[3],P1[4],P1[5],     pw2[0]=PKW(P1,0), pw2[1]=PKW(P1,2), pw2); \
    VRD(6); SBAR(); GAPA(C1=__builtin_amdgcn_mfma_f32_32x32x16_bf16(kf[5],qr[2],C1,0,0,0),   P1[6],P1[7],P1[8],P1[9],     pw2[2]=PKW(P1,4), pw2[3]=PKW(P1,6), pw2); \
    VRD(3); SBAR(); GAPA(C0=__builtin_amdgcn_mfma_f32_32x32x16_bf16(kf[6],qr[3],C0,0,0,0),   P1[10],P1[11],P1[12],P1[13], pw3[0]=PKW(P1,8), pw3[1]=PKW(P1,10), pw3); \
    VRD(7); SBAR(); GAPA(C1=__builtin_amdgcn_mfma_f32_32x32x16_bf16(kf[7],qr[3],C1,0,0,0),   P1[14],P1[15],0.f,0.f,       pw3[2]=PKW(P1,12),pw3[3]=PKW(P1,14), pw3); \
    l_reg+=sacc; \
    if(GK){DMA_K((t)+3,sl_cur);} if(GV){DMA_V((t)+1,sl_next);} \
    CMASK(C0,C1,t); \
    { float a=MX3(C0[0],C0[1],C1[0]),b=MX3(C0[2],C0[3],C1[1]); a=MX3(a,C1[2],C1[3]); \
      _Pragma("unroll") for(int r=4;r<16;r+=4){a=MX3(a,C0[r],C0[r+1]);b=MX3(b,C0[r+2],C0[r+3]);a=MX3(a,C1[r],C1[r+1]);b=MX3(b,C1[r+2],C1[r+3]);} \
      float rm=__builtin_fmaxf(a,b); { auto rr=__builtin_amdgcn_permlane32_swap(__float_as_uint(rm),__float_as_uint(rm),false,false); rm=__builtin_fmaxf(__uint_as_float(rr[0]),__uint_as_float(rr[1])); } \
      resc=false; \
      if(__builtin_expect(__any(rm>(float)THRL),0)){ const float dl=__builtin_fmaxf(rm,0.f); mhat+=dl; \
        _Pragma("unroll") for(int r=0;r<16;++r){C0[r]-=dl;C1[r]-=dl;} \
        if constexpr(!NONEG){ _Pragma("unroll") for(int r=0;r<16;++r)negm[r]=-mhat; asm volatile("":"+v"(negm)); } \
        const float f=__builtin_amdgcn_exp2f(-dl); l_reg*=f; if(hi==0)wsf[r32]=f; resc=true; } } \
    SBAR(); \
    GAPB(o[0]=__builtin_amdgcn_mfma_f32_32x32x16_bf16(PAF(0),VFR(0),o[0],0,0,0), C0,0); \
    GAPB(o[1]=__builtin_amdgcn_mfma_f32_32x32x16_bf16(PAF(0),VFR(4),o[1],0,0,0), C0,4); \
    KRD(GL,0); GAPB(o[0]=__builtin_amdgcn_mfma_f32_32x32x16_bf16(PAF(1),VFR(1),o[0],0,0,0), C0,8); \
    KRD(GL,1); GAPB(o[1]=__builtin_amdgcn_mfma_f32_32x32x16_bf16(PAF(1),VFR(5),o[1],0,0,0), C0,12); \
    KRD(GL,2); GAPB(o[0]=__builtin_amdgcn_mfma_f32_32x32x16_bf16(PAF(2),VFR(2),o[0],0,0,0), C1,0); \
    KRD(GL,3); GAPB(o[1]=__builtin_amdgcn_mfma_f32_32x32x16_bf16(PAF(2),VFR(6),o[1],0,0,0), C1,4); \
    GAPB(o[0]=__builtin_amdgcn_mfma_f32_32x32x16_bf16(PAF(3),VFR(3),o[0],0,0,0), C1,8); \
    GAPB(o[1]=__builtin_amdgcn_mfma_f32_32x32x16_bf16(PAF(3),VFR(7),o[1],0,0,0), C1,12); \
    }while(0)
  int t=1;
  for(;t+5<NT;t+=2){
    STEP(pB0,pB1,pA0,pA1,t,true,true,true);     WAIT_BAR(2); RESC(); ROT();
    STEP(pA0,pA1,pB0,pB1,t+1,true,true,true);   WAIT_BAR(2); RESC(); ROT();
  }
  #undef CMASK
  #define CMASK(P0,P1,t) do{ if constexpr(NONEG&&!WIN){ _Pragma("unroll") for(int r=0;r<16;++r){ P0[r]-=mhat; P1[r]-=mhat; } } if constexpr(WIN){ const __attribute__((address_space(3))) float*tb_=tbl+ib+64*(t); _Pragma("unroll") for(int r=0;r<16;++r){ P0[r]+=tb_[(r&3)+8*(r>>2)]-mhat; P1[r]+=tb_[(r&3)+8*(r>>2)+32]-mhat; } } }while(0)
  #define ENDW(tt) do{ if((tt)+3<NT){WAIT_BAR(2);} else if((tt)+2<NT){WAIT_BAR(1);} else {WAIT_BAR(0);} }while(0)
  for(;t+1<NT;t+=2){
    STEP(pB0,pB1,pA0,pA1,t,(t+3<NT),(t+1<NT),(t+1<NT));       ENDW(t);   RESC(); ROT();
    STEP(pA0,pA1,pB0,pB1,t+1,(t+4<NT),(t+2<NT),(t+2<NT));     ENDW(t+1); RESC(); ROT();
  }
  STEP(pB0,pB1,pA0,pA1,NT-1,false,false,false); RESC();
  { float sacc=pB0[0]+pB0[1]; _Pragma("unroll") for(int r=2;r<16;++r)sacc+=pB0[r]; _Pragma("unroll") for(int r=0;r<16;++r)sacc+=pB1[r]; l_reg+=sacc;
    pw0=(u32x4){PKW(pB0,0),PKW(pB0,2),PKW(pB0,4),PKW(pB0,6)};pw1=(u32x4){PKW(pB0,8),PKW(pB0,10),PKW(pB0,12),PKW(pB0,14)};pw2=(u32x4){PKW(pB1,0),PKW(pB1,2),PKW(pB1,4),PKW(pB1,6)};pw3=(u32x4){PKW(pB1,8),PKW(pB1,10),PKW(pB1,12),PKW(pB1,14)};
    SBAR(); pv(o,vb0+sl_cur,PAF(0),PAF(1),PAF(2),PAF(3)); }
  #undef PKW
  #undef PAF
  #undef VFR
  #undef PIN
  #undef MX3
  #undef GAPA
  #undef GAPB
  #undef EX
  #undef VRD
  #undef KRD
  #undef STEP
  #undef ENDW
  {auto rr=__builtin_amdgcn_permlane32_swap(__float_as_uint(l_reg),__float_as_uint(l_reg),false,false);l_reg=__uint_as_float(rr[0])+__uint_as_float(rr[1]);}
  if constexpr(WIN) l_reg+=__builtin_amdgcn_exp2f(sinkL2-mhat);
  if(hi==0)wsf[32+r32]=l_reg;asm volatile("s_waitcnt lgkmcnt(0)":::"memory");
  float rli[16];
  #pragma unroll
  for(int r=0;r<16;++r)rli[r]=__builtin_amdgcn_rcpf(wsf[32+crow(r,hi)]);
  bf16*Ow=O+(rowbase+q0+wid*QBLK)*OP+OC+h*D;
  { bf16*stg=(bf16*)(shm+LDS_OST)+wid*2048;
    #pragma unroll
    for(int r=0;r<16;++r){const int orow=crow(r,hi);
      #pragma unroll
      for(int d0=0;d0<2;++d0)stg[orow*64+d0*32+r32]=__float2bfloat16(o[d0][r]*rli[r]);}
    asm volatile("s_waitcnt lgkmcnt(0)":::"memory");
    #pragma unroll
    for(int i=0;i<4;++i){const int row=i*8+(lane>>3),ch=lane&7; const u32x4 v=*(const u32x4*)(stg+row*64+ch*8); ATTN_STORE16(Ow+(long)row*OP+ch*8,v);} }
  asm volatile("s_waitcnt lgkmcnt(0)\n\ts_barrier":::"memory");
  #undef DMA_K
  #undef DMA_V
  #undef CMASK
  #undef START
  #undef RESC
  #undef ROT
}
constexpr int ATTN_LDS_BYTES=LDS_TBL+TBLN*4;
#undef SBAR
#undef WAIT_BAR
}
__device__ __forceinline__ unsigned ln_f2bf(float f) { unsigned u = __builtin_bit_cast(unsigned, f); return (u + 0x7fffu + ((u >> 16) & 1u)) >> 16; }
__device__ __forceinline__ unsigned ln_pk2(float lo, float hi) { return ln_f2bf(lo) | (ln_f2bf(hi) << 16); }
__device__ __forceinline__ void ln_rows(const float* in, float* out32, unsigned short* outbf, const float* g, const float* b, int gw, int NGW, int lane) {
    typedef float f32x4 __attribute__((ext_vector_type(4))); typedef unsigned v2u __attribute__((ext_vector_type(2)));
    f32x4 gv[4], bv[4];
#pragma unroll
    for (int j = 0; j < 4; ++j) { gv[j] = *(const f32x4*)(g + 4 * lane + 256 * j); bv[j] = *(const f32x4*)(b + 4 * lane + 256 * j); }
    for (int m = gw; m < 32768; m += NGW) {
        const float* xr = in + (size_t)m * 1024 + 4 * lane;
        f32x4 v[4]; float s = 0.f;
#pragma unroll
        for (int j = 0; j < 4; ++j) { v[j] = *(const f32x4*)(xr + 256 * j); s += (v[j][0] + v[j][1]) + (v[j][2] + v[j][3]); }
        float t = s;
#pragma unroll
        for (int o = 1; o < 64; o <<= 1) t += __shfl_xor(t, o);
        const float mean = t * (1.f / 1024.f); float s2 = 0.f;
#pragma unroll
        for (int j = 0; j < 4; ++j) { v[j] = v[j] - mean; s2 += (v[j][0] * v[j][0] + v[j][1] * v[j][1]) + (v[j][2] * v[j][2] + v[j][3] * v[j][3]); }
#pragma unroll
        for (int o = 1; o < 64; o <<= 1) s2 += __shfl_xor(s2, o);
        const float rstd = rsqrtf(s2 * (1.f / 1024.f) + 1e-5f);
        float* o32 = out32 + (size_t)m * 1024 + 4 * lane; unsigned short* o16 = outbf + (size_t)m * 1024 + 4 * lane;
#pragma unroll
        for (int j = 0; j < 4; ++j) { const f32x4 y = v[j] * rstd * gv[j] + bv[j]; *(f32x4*)(o32 + 256 * j) = y;
            v2u w; w.x = ln_pk2(y[0], y[1]); w.y = ln_pk2(y[2], y[3]);
            *(v2u*)(o16 + 256 * j) = w; }
    }
}
#define LAS __attribute__((address_space(3)))
typedef unsigned short bf16raw;
typedef unsigned v4u __attribute__((ext_vector_type(4)));
typedef unsigned v2u __attribute__((ext_vector_type(2)));
typedef float f32x4 __attribute__((ext_vector_type(4)));

constexpr int NWAVES = 8, NTHR = 512;
constexpr int BATCH = 4, SEQ = 8192, DM = 1024, M = BATCH * SEQ, INC = 1536, FF = 2816, NGU = 2 * FF, DEPTH = 2;
constexpr float ALPHA = 1.4142135623730951f;
constexpr float RMS_EPS = 1e-6f, LN_EPS = 1e-5f;
constexpr float LOG2E = 1.4426950408889634f;
constexpr int LDS_BYTES = 147456;
constexpr size_t MiB = 1u << 20;
constexpr size_t WS_TBL = 0;
constexpr size_t WS_W = 1 * MiB, W_LAYER = 22 * MiB;
constexpr size_t WO_IN = 0, WO_OUT = 3 * MiB, WO_GU = 5 * MiB, WO_DN = 16 * MiB;
constexpr size_t WS_XN = 45 * MiB;
constexpr size_t WS_X1 = 109 * MiB;
constexpr size_t WS_H = 237 * MiB;
constexpr size_t WS_Y = 333 * MiB;
constexpr size_t WS_HH = 237 * MiB;
constexpr size_t WS_SIDE = 413 * MiB;
constexpr size_t WS_END = WS_SIDE + (size_t)512 * 2 * 3 * FF * 4;
static_assert(WS_HH + (size_t)M * FF * 2 <= WS_SIDE && WS_Y + (size_t)M * DM * 2 <= WS_END && WS_H + (size_t)M * INC * 2 <= WS_Y, "ws map");

__device__ __forceinline__ unsigned f2bf(float f) { unsigned u = __builtin_bit_cast(unsigned, f); return (u + 0x7fffu + ((u >> 16) & 1u)) >> 16; }
__device__ __forceinline__ unsigned pk2(float lo, float hi) { return f2bf(lo) | (f2bf(hi) << 16); }
__device__ __forceinline__ float bf2f(unsigned short h) { return __builtin_bit_cast(float, (unsigned)h << 16); }
__device__ __forceinline__ float wave_sum(float v) {
#pragma unroll
    for (int o = 1; o < 64; o <<= 1) v += __shfl_xor(v, o);
    return v;
}

__device__ __forceinline__ void transpose_item(const float* W, int K, int N, bf16raw* WT, int k0, int n0, int dst0, LAS float* scr, int lane) {
#pragma unroll 8
    for (int i = 0; i < 32; ++i) { const int kk = 2 * i + (lane >> 5); scr[kk * 33 + (lane & 31)] = W[(size_t)(k0 + kk) * N + n0 + (lane & 31)]; }
    asm volatile("s_waitcnt lgkmcnt(0)" ::: "memory");
    const int c = lane & 7;
#pragma unroll
    for (int j = 0; j < 4; ++j) { const int n = (lane >> 3) + 8 * j; const LAS float* s = scr + (8 * c) * 33 + n;
        v4u o; o.x = pk2(s[0 * 33], s[1 * 33]); o.y = pk2(s[2 * 33], s[3 * 33]); o.z = pk2(s[4 * 33], s[5 * 33]); o.w = pk2(s[6 * 33], s[7 * 33]);
        *(v4u*)(WT + (size_t)(dst0 + n) * K + k0 + 8 * c) = o; }
    asm volatile("s_waitcnt lgkmcnt(0)" ::: "memory");
}

#define RLX_AGENT __ATOMIC_RELAXED, __HIP_MEMORY_SCOPE_AGENT
#define XB_TMO      128
#define XB_XCNT(j)  (256  + 64 * (j))
#define XB_XSUB(j)  (1280 + 64 * (j))
#define XB_XGEN(j)  (2304 + 64 * (j))
#define XB_TOP      3328
#define XB_TOPGEN   3392
#define XCD_BAR_WORDS 3456
#define XB_SPIN_CAP (1u << 18)

__device__ __forceinline__ unsigned xb_ld(unsigned* p)              { return __hip_atomic_load(p, __ATOMIC_RELAXED, __HIP_MEMORY_SCOPE_AGENT); }
__device__ __forceinline__ unsigned xb_add(unsigned* p, unsigned v) { return __hip_atomic_fetch_add(p, v, __ATOMIC_RELAXED, __HIP_MEMORY_SCOPE_AGENT); }
__device__ __forceinline__ unsigned xb_xcc_id() { return (unsigned)__builtin_amdgcn_s_getreg((3 << 11) | 20) & 0xFu; }
#define XB_SPIN(cond, bar) do { unsigned _sp = 0; while (cond) { __builtin_amdgcn_s_sleep(1); \
    if ((++_sp & 255u) == 0u) { if (xb_ld(&(bar)[XB_TMO])) break; if (_sp > XB_SPIN_CAP) { atomicAdd(&(bar)[XB_TMO], 1u); break; } } } } while (0)

struct XcdBarrier {
    unsigned* bar; unsigned x;
    volatile LAS unsigned* st;
};

__device__ __forceinline__ XcdBarrier xcd_barrier_post(unsigned* bar, volatile LAS unsigned* st) {
    XcdBarrier b; b.bar = bar; b.x = xb_xcc_id(); b.st = st;
    if (threadIdx.x == 0) (void)xb_add(&bar[XB_XCNT(b.x)], 1u);
    return b;
}
__device__ __forceinline__ void xcd_barrier_complete(unsigned* bar, unsigned x, unsigned& nloc, unsigned& nx) {
    const unsigned G = gridDim.x * gridDim.y * gridDim.z;
    unsigned sum, cnt, mine, sp = 0u;
    for (;;) {
        sum = 0u; cnt = 0u; mine = 0u;
#pragma unroll
        for (unsigned j = 0; j < 16; ++j) { const unsigned c = xb_ld(&bar[XB_XCNT(j)]); sum += c; cnt += (c > 0u) ? 1u : 0u; mine = (j == x) ? c : mine; }
        if (sum == G) break;
        __builtin_amdgcn_s_sleep(1);
        if ((++sp & 255u) == 0u) { if (xb_ld(&bar[XB_TMO])) break; if (sp > XB_SPIN_CAP) { atomicAdd(&bar[XB_TMO], 1u); break; } }
    }
    nloc = mine > 0u ? mine : 1u; nx = cnt > 0u ? cnt : 1u;
}

__device__ __forceinline__ void xcd_barrier(const XcdBarrier& b) {
    asm volatile("s_waitcnt vmcnt(0)" ::: "memory");
    __syncthreads();
    if (threadIdx.x == 0) {
        unsigned* bar = b.bar;
        __builtin_amdgcn_s_waitcnt(0);
        unsigned nloc = b.st[0], nx = b.st[1];
        if (nloc == 0u) { xcd_barrier_complete(bar, b.x, nloc, nx); b.st[0] = nloc; b.st[1] = nx; }
        const unsigned old = xb_add(&bar[XB_XSUB(b.x)], 1u);
        const unsigned gen = old / nloc;
        if (old + 1u == (gen + 1u) * nloc) {
            __builtin_amdgcn_fence(__ATOMIC_RELEASE, "agent");
            asm volatile("s_waitcnt vmcnt(0)" ::: "memory");
            const unsigned og = xb_add(&bar[XB_TOP], 1u);
            const unsigned tg = og / nx;
            if (og + 1u == (tg + 1u) * nx) xb_add(&bar[XB_TOPGEN], 1u);
            else XB_SPIN(xb_ld(&bar[XB_TOPGEN]) == tg, bar);
            __builtin_amdgcn_fence(__ATOMIC_ACQUIRE, "agent");
            xb_add(&bar[XB_XGEN(b.x)], 1u);
            asm volatile("s_waitcnt vmcnt(0)" ::: "memory");
        } else {
            XB_SPIN(xb_ld(&bar[XB_XGEN(b.x)]) == gen, bar);
            __builtin_amdgcn_fence(__ATOMIC_ACQUIRE, "agent");
            asm volatile("s_waitcnt vmcnt(0)" ::: "memory");
        }
    }
    __syncthreads();
}

constexpr size_t WS_BAR = 64 * 1024;
constexpr int LDS_BARST = 131072 + 512;
#ifdef DBG_CHECKS
constexpr size_t WS_FLAGS = 512 * 1024;
__device__ __forceinline__ unsigned hsh(unsigned x) { x ^= x >> 16; x *= 0x7feb352dU; x ^= x >> 15; x *= 0x846ca68bU; x ^= x >> 16; return x; }
__device__ __forceinline__ float rbf(float f) { return bf2f((unsigned short)f2bf(f)); }
__device__ __forceinline__ float dot_aw(const bf16raw* a, const float* W, int col, int N, int K, int lane) {
    float s = 0.f; for (int k = lane; k < K; k += 64) s += bf2f(a[k]) * rbf(W[(size_t)k * N + col]); return wave_sum(s);
}
__device__ __forceinline__ void flag_if(unsigned* flags, bool bad, unsigned bit, int lane) { if (bad && lane == 0) atomicOr(flags, bit); }
#endif

struct Args { const float* in[18]; float* out; unsigned char* ws; };
typedef const __attribute__((address_space(4))) Args* ArgsP;
__device__ __forceinline__ ArgsP args_ptr() { ArgsP p = (ArgsP)__builtin_amdgcn_kernarg_segment_ptr(); asm volatile("" : "+s"(p)); return p; }
#define ARGS() const ArgsP ap = args_ptr(); unsigned char* const ws = ap->ws; (void)ws

__device__ __forceinline__ int t5_bucket(int rel) {
    const int rp = rel < 0 ? -rel : rel; int v;
    if (rp < 8) v = rp; else if (rp < 12) v = 8; else if (rp < 16) v = 9; else if (rp < 23) v = 10; else if (rp < 32) v = 11; else if (rp < 46) v = 12; else if (rp < 64) v = 13; else if (rp < 91) v = 14; else v = 15;
    return (rel > 0 ? 16 : 0) + v;
}

#define GSYNC() xcd_barrier(xbar)
__global__ void __launch_bounds__(NTHR, 2) fwd_kernel(Args a) {
    extern __shared__ __attribute__((aligned(16))) unsigned char lds[];
    cg::grid_group grid = cg::this_grid();
    const int G = gridDim.x, bx = blockIdx.x;
    const int vcu = (G % 8 == 0) ? (bx % 8) * (G / 8) + bx / 8 : bx;
    const int NGW = G * NWAVES, NGT = G * NTHR;
#define IDS() int tid_ = threadIdx.x; asm volatile("" : "+v"(tid_)); const int tid = tid_, lane = tid & 63, wave = __builtin_amdgcn_readfirstlane(tid >> 6); const int gw = vcu * NWAVES + wave, gt = bx * NTHR + tid; (void)lane; (void)gw; (void)gt
#define XN_ ((bf16raw*)(ws + WS_XN))
#define X1_ ((float*)(ws + WS_X1))
#define HB_ ((bf16raw*)(ws + WS_H))
#define YB_ ((bf16raw*)(ws + WS_Y))
#define HH_ ((bf16raw*)(ws + WS_HH))
#define SIDE_ ((float*)(ws + WS_SIDE))
#define TBL_ ((float*)(ws + WS_TBL))
#define WL_ (ws + WS_W + (size_t)l * W_LAYER)
    LAS unsigned char* ldsp = (LAS unsigned char*)lds;

    { ARGS(); IDS(); if (tid < 2) ((LAS unsigned*)((LAS unsigned char*)lds + LDS_BARST))[tid] = 0u;
      if (bx == 0) for (int i = tid; i < XCD_BAR_WORDS; i += NTHR) ((unsigned*)(ws + WS_BAR))[i] = 0u; }
    {
        ARGS(); IDS(); const float* x_in = ap->in[0]; bf16raw* XN = XN_; float* tblG = TBL_;
        LAS float* scr = (LAS float*)((LAS unsigned char*)lds + wave * 16384);
        constexpr int I_IN = (DM / 64) * (INC / 32), I_OUT = (DM / 64) * (DM / 32), I_G = (DM / 64) * (FF / 32), I_DN = (FF / 64) * (DM / 32);
        constexpr int I_LAYER = I_IN + I_OUT + 2 * I_G + I_DN;
        for (int it = gw; it < DEPTH * I_LAYER; it += NGW) {
            const int l = it / I_LAYER; int r = it % I_LAYER;
            unsigned char* wl = ws + WS_W + (size_t)l * W_LAYER;
            if (r < I_IN) { const int nblk = INC / 32, kb = r / nblk, nb = r % nblk;
                transpose_item(ap->in[2] + (size_t)l * DM * INC, DM, INC, (bf16raw*)(wl + WO_IN), 64 * kb, 32 * nb, 32 * nb, scr, lane); continue; } r -= I_IN;
            if (r < I_OUT) { const int nblk = DM / 32, kb = r / nblk, nb = r % nblk;
                transpose_item(ap->in[8] + (size_t)l * DM * DM, DM, DM, (bf16raw*)(wl + WO_OUT), 64 * kb, 32 * nb, 32 * nb, scr, lane); continue; } r -= I_OUT;
            if (r < 2 * I_G) { const int up = r >= I_G ? 1 : 0; if (up) r -= I_G; const int nblk = FF / 32, kb = r / nblk, nb = r % nblk, n0 = 32 * nb;
                transpose_item((up ? ap->in[12] : ap->in[11]) + (size_t)l * DM * FF, DM, FF, (bf16raw*)(wl + WO_GU), 64 * kb, n0, (n0 / 128) * 256 + (n0 % 128) + up * 128, scr, lane); continue; } r -= 2 * I_G;
            { const int nblk = DM / 32, kb = r / nblk, nb = r % nblk;
                transpose_item(ap->in[15] + (size_t)l * FF * DM, FF, DM, (bf16raw*)(wl + WO_DN), 64 * kb, 32 * nb, 32 * nb, scr, lane); }
        }
        for (size_t i = gt; i < (size_t)M * DM / 8; i += NGT) {
            const f32x4 v0 = *(const f32x4*)(x_in + i * 8), v1 = *(const f32x4*)(x_in + i * 8 + 4);
            v4u o; o.x = pk2(v0[0], v0[1]); o.y = pk2(v0[2], v0[3]); o.z = pk2(v1[0], v1[1]); o.w = pk2(v1[2], v1[3]);
            *(v4u*)(XN + i * 8) = o;
        }
#ifdef DBG_CHECKS
        if (gt == 0) { *(unsigned*)(ws + WS_FLAGS) = 0u; *((unsigned*)(ws + WS_FLAGS) + 1) = 0u; *((unsigned*)(ws + WS_FLAGS) + 2) = 0u; }
#endif
        for (int i = gt; i < 8 * attn_body::TBLN; i += NGT) {
            const int h = i / attn_body::TBLN, rel = i % attn_body::TBLN - 384;
            float v = -1000.f;
            if (rel >= -128 && rel <= 128) v = ap->in[1][t5_bucket(rel) * 8 + h] * LOG2E;
            tblG[i] = v;
        }
    }
    grid.sync();
    XcdBarrier xbar; { ARGS(); xbar = xcd_barrier_post((unsigned*)(ws + WS_BAR), (volatile LAS unsigned*)((LAS unsigned char*)lds + LDS_BARST)); }

#if defined(DBG_CHECKS) && (DBG_CHECKS & 128)
    {
        ARGS(); IDS(); unsigned* flags = (unsigned*)(ws + WS_FLAGS); unsigned* rec = (unsigned*)(ws + WS_X1);
        for (int round = 1; round <= 40; ++round) {
            const int slot = (bx + round * 37) % G; for (int i = tid; i < 1024; i += NTHR) rec[(size_t)slot * 1024 + i] = (unsigned)round * 65536u + (unsigned)slot;
            GSYNC();
            unsigned bad = 0;
            for (int j = tid; j < G * 16; j += NTHR) { const int b2 = j >> 4, i = (j & 15) * 64 + (round & 63); if (rec[(size_t)b2 * 1024 + i] != (unsigned)round * 65536u + (unsigned)b2) bad = 1; }
            if (bad) atomicOr(flags, 8u);
            GSYNC();
        }
    }
#endif
    for (int l = 0; l < DEPTH; ++l) {
        {
            ARGS(); IDS(); pg8::Gemm g{XN_, (const bf16raw*)(WL_ + WO_IN), M, INC, DM}; pg8::StaticOrder S; S.init(M, INC, G, bx);
            pg8::EpiInProj E{HB_, INC, attn_body::C2};
            pg8::gemm_phase<pg8::EpiInProj, pg8::StaticOrder, true, true>(ldsp, g, S, E);
        }
        GSYNC();
#if defined(DBG_CHECKS) && (DBG_CHECKS & 1)
        {
            ARGS(); IDS(); unsigned* flags = (unsigned*)(ws + WS_FLAGS);
            if (gw < 512) { const unsigned h0 = hsh(gw * 2 + 1 + 7919 * l); const int r = h0 % M, c = (gw < 64) ? (gw * 24 + (h0 >> 20) % 24) : hsh(h0) % INC;
                float ref = dot_aw(XN_ + (size_t)r * DM, ap->in[2] + (size_t)l * DM * INC, c, INC, DM, lane);
                if (c >= 768 && c < 1280) ref *= attn_body::C2;
                const float got = bf2f(HB_[(size_t)r * INC + c]);
                flag_if(flags, !(fabsf(got - ref) <= 0.02f + 0.02f * fabsf(ref)), 1u, lane); }
        }
        GSYNC();
#endif
        {
            ARGS(); IDS(); bf16raw* Hb = HB_; const float* qn = ap->in[3] + l * 64; const float* kn = ap->in[4] + l * 64;
            const int sub = lane & 15;
            for (int it4 = gw; it4 < M * 10 / 4; it4 += NGW) {
                const int item = it4 * 4 + (lane >> 4); const int m = item / 10, hh = item % 10;
                const int col = (hh < 8) ? 64 * hh : 512 + 64 * (hh - 8);
                const float* gn = (hh < 8) ? qn : kn;
                bf16raw* p = Hb + (size_t)m * INC + col + 4 * sub;
                const v2u raw = *(const v2u*)p;
                float x0 = bf2f((unsigned short)(raw.x & 0xffffu)), x1 = bf2f((unsigned short)(raw.x >> 16)), x2 = bf2f((unsigned short)(raw.y & 0xffffu)), x3 = bf2f((unsigned short)(raw.y >> 16));
                float ss = (x0 * x0 + x1 * x1) + (x2 * x2 + x3 * x3);
                ss += __shfl_xor(ss, 1); ss += __shfl_xor(ss, 2); ss += __shfl_xor(ss, 4); ss += __shfl_xor(ss, 8);
                const float rinv = rsqrtf(ss * (1.0f / 64.0f) + RMS_EPS);
                const f32x4 gv = *(const f32x4*)(gn + 4 * sub);
                x0 = x0 * rinv * gv[0]; x1 = x1 * rinv * gv[1]; x2 = x2 * rinv * gv[2]; x3 = x3 * rinv * gv[3];
                const int s = m & (SEQ - 1); const float pos = (float)((sub < 8) ? (s >> 6) : (s & 63));
                const int fi0 = (2 * sub) & 15, fi1 = (2 * sub + 1) & 15;
                const float if0 = exp2f(-(float)fi0 * (13.287712379549449f / 16.0f)), if1 = exp2f(-(float)fi1 * (13.287712379549449f / 16.0f));
                float r0 = (pos * if0) * 0.15915494309189535f, r1 = (pos * if1) * 0.15915494309189535f;
                r0 -= floorf(r0); r1 -= floorf(r1);
                const float c0 = __builtin_amdgcn_cosf(r0), s0 = __builtin_amdgcn_sinf(r0), c1 = __builtin_amdgcn_cosf(r1), s1 = __builtin_amdgcn_sinf(r1);
                const float sc = (hh < 8) ? attn_body::C2 : 1.0f;
                const float y0 = (x0 * c0 - x1 * s0) * sc, y1 = (x0 * s0 + x1 * c0) * sc, y2 = (x2 * c1 - x3 * s1) * sc, y3 = (x2 * s1 + x3 * c1) * sc;
                v2u o; o.x = pk2(y0, y1); o.y = pk2(y2, y3);
                *(v2u*)p = o;
            }
        }
        GSYNC();
        {
            ARGS(); IDS(); bf16raw* Hb = HB_; bf16raw* Yb = YB_; float* tblG = TBL_; const float* sink = ap->in[5] + l * 8;
            for (int uid = vcu; uid < 1024; uid += G) {
                const int v = uid & 255, i = uid >> 8, s = v & 7, bh = v >> 3;
                const int qb = (i == 0) ? s : (i == 1) ? 15 - s : (i == 2) ? 16 + s : 31 - s;
                attn_body::attn_unit<8, false>(bh >> 3, bh & 7, qb, (const attn_body::bf16*)Hb, (attn_body::bf16*)Yb, (char*)lds, nullptr, 0.f);
            }
            for (int uid = vcu; uid < 1024; uid += G) {
                const int v = uid & 255, i = uid >> 8, s = v & 7, bh = v >> 3;
                const int qb = (i == 0) ? s : (i == 1) ? 15 - s : (i == 2) ? 16 + s : 31 - s;
                attn_body::attn_unit<8, true>(bh >> 3, bh & 7, qb, (const attn_body::bf16*)Hb, (attn_body::bf16*)Yb, (char*)lds, tblG + (bh & 7) * attn_body::TBLN, sink[bh & 7] * LOG2E);
            }
        }
        GSYNC();
#if defined(DBG_CHECKS) && (DBG_CHECKS & 2)
        {
            ARGS(); IDS(); unsigned* flags = (unsigned*)(ws + WS_FLAGS); const bf16raw* Hb = HB_; const bf16raw* Yb = YB_; const float* tblG = TBL_;
            if (gw < 256) { const unsigned h0 = hsh(gw * 2 + 77 + 131 * l); const int win = gw & 1; const int b = (h0 >> 3) & 3, h = h0 & 7;
                int q = (h0 >> 8) & (SEQ - 1); if ((gw >> 1) % 8 == 0) q = ((h0 >> 8) & 31) * 256 + ((gw & 32) ? 255 : 0); if ((gw >> 1) % 8 == 1) q = (gw & 32) ? SEQ - 1 - ((h0 >> 8) & 127) : ((h0 >> 8) & 127);
                const int QC = win ? 768 : 0, KC = win ? 1280 : 512, VC = win ? 1408 : 640, OC = win ? 512 : 0;
                const bf16raw* qp = Hb + ((size_t)b * SEQ + q) * INC + QC + h * 64;
                const int klo = win ? (q - 128 < 0 ? 0 : q - 128) : 0, khi = win ? (q + 128 > SEQ - 1 ? SEQ - 1 : q + 128) : SEQ - 1;
                float mx = -1e30f;
                for (int k = klo + lane; k <= khi; k += 64) { const bf16raw* kp = Hb + ((size_t)b * SEQ + k) * INC + KC + (h >> 2) * 64; float s = 0.f; for (int d = 0; d < 64; ++d) s += bf2f(qp[d]) * bf2f(kp[d]); if (win) s += tblG[h * attn_body::TBLN + (k - q) + 384]; mx = fmaxf(mx, s); }
#pragma unroll
                for (int o = 1; o < 64; o <<= 1) mx = fmaxf(mx, __shfl_xor(mx, o));
                float den = 0.f, o0 = 0.f, o1 = 0.f, o2 = 0.f, o3 = 0.f;
                for (int k = klo + lane; k <= khi; k += 64) { const bf16raw* kp = Hb + ((size_t)b * SEQ + k) * INC + KC + (h >> 2) * 64; const bf16raw* vp = Hb + ((size_t)b * SEQ + k) * INC + VC + (h >> 2) * 64; float s = 0.f; for (int d = 0; d < 64; ++d) s += bf2f(qp[d]) * bf2f(kp[d]); if (win) s += tblG[h * attn_body::TBLN + (k - q) + 384];
                    const float p = exp2f(s - mx); den += p; o0 += p * bf2f(vp[0]); o1 += p * bf2f(vp[17]); o2 += p * bf2f(vp[42]); o3 += p * bf2f(vp[63]); }
                den = wave_sum(den); o0 = wave_sum(o0); o1 = wave_sum(o1); o2 = wave_sum(o2); o3 = wave_sum(o3);
                if (win) den += exp2f(ap->in[5][l * 8 + h] * LOG2E - mx);
                const bf16raw* yp = Yb + ((size_t)b * SEQ + q) * DM + OC + h * 64;
                const float e0 = fabsf(bf2f(yp[0]) - o0 / den), e1 = fabsf(bf2f(yp[17]) - o1 / den), e2 = fabsf(bf2f(yp[42]) - o2 / den), e3 = fabsf(bf2f(yp[63]) - o3 / den);
                const float em = fmaxf(fmaxf(e0, e1), fmaxf(e2, e3));
                flag_if(flags, !(em <= 0.02f), win ? 4u : 2u, lane); }
        }
        GSYNC();
#endif
        {
            ARGS(); IDS(); bf16raw* Yb = YB_; const float* ga = ap->in[6] + l * 512; const float* gb = ap->in[7] + l * 512;
            f32x4 gA0 = *(const f32x4*)(ga + 8 * lane), gA1 = *(const f32x4*)(ga + 8 * lane + 4), gB0 = *(const f32x4*)(gb + 8 * lane), gB1 = *(const f32x4*)(gb + 8 * lane + 4);
            for (int m = gw; m < M; m += NGW) {
                bf16raw* pa = Yb + (size_t)m * DM + 8 * lane; bf16raw* pb = pa + 512;
                const v4u ra = *(const v4u*)pa, rb = *(const v4u*)pb;
                float va[8], vb[8];
#pragma unroll
                for (int j = 0; j < 4; ++j) { va[2 * j] = bf2f((unsigned short)(ra[j] & 0xffffu)); va[2 * j + 1] = bf2f((unsigned short)(ra[j] >> 16)); vb[2 * j] = bf2f((unsigned short)(rb[j] & 0xffffu)); vb[2 * j + 1] = bf2f((unsigned short)(rb[j] >> 16)); }
                float sa = 0.f, sb = 0.f;
#pragma unroll
                for (int j = 0; j < 8; ++j) { sa += va[j] * va[j]; sb += vb[j] * vb[j]; }
                sa = wave_sum(sa); sb = wave_sum(sb);
#ifdef ZERO_A
                for (int j = 0; j < 8; ++j) va[j] = 0.f;
#endif
#ifdef ZERO_B
                for (int j = 0; j < 8; ++j) vb[j] = 0.f;
#endif
                const float rA = rsqrtf(sa * (1.0f / 512.0f) + RMS_EPS), rB = rsqrtf(sb * (1.0f / 512.0f) + RMS_EPS);
                v4u oa, ob;
                oa.x = pk2(va[0] * rA * gA0[0], va[1] * rA * gA0[1]); oa.y = pk2(va[2] * rA * gA0[2], va[3] * rA * gA0[3]); oa.z = pk2(va[4] * rA * gA1[0], va[5] * rA * gA1[1]); oa.w = pk2(va[6] * rA * gA1[2], va[7] * rA * gA1[3]);
                ob.x = pk2(vb[0] * rB * gB0[0], vb[1] * rB * gB0[1]); ob.y = pk2(vb[2] * rB * gB0[2], vb[3] * rB * gB0[3]); ob.z = pk2(vb[4] * rB * gB1[0], vb[5] * rB * gB1[1]); ob.w = pk2(vb[6] * rB * gB1[2], vb[7] * rB * gB1[3]);
                *(v4u*)pa = oa; *(v4u*)pb = ob;
            }
        }
        GSYNC();
        {
            ARGS(); IDS(); const float* xres = (l == 0) ? ap->in[0] : ap->out;
            pg8::Gemm g{YB_, (const bf16raw*)(WL_ + WO_OUT), M, DM, DM}; pg8::StaticOrder S; S.init(M, DM, G, bx);
            pg8::EpiRes E{xres, ap->out, DM, ALPHA, 1.0f};
            pg8::gemm_phase<pg8::EpiRes, pg8::StaticOrder, true, true>(ldsp, g, S, E);
        }
        GSYNC();
#if defined(DBG_CHECKS) && (DBG_CHECKS & 4)
        {
            ARGS(); IDS(); unsigned* flags = (unsigned*)(ws + WS_FLAGS); const float* xres = (l == 0) ? ap->in[0] : ap->out;
            if (gw < 512) { const unsigned h0 = hsh(gw * 2 + 3 + 104729 * l); const int r = h0 % M, c = hsh(h0) % DM;
                const float ref = ALPHA * xres[(size_t)r * DM + c] + dot_aw(YB_ + (size_t)r * DM, ap->in[8] + (size_t)l * DM * DM, c, DM, DM, lane);
                const float got = ap->out[(size_t)r * DM + c];
                flag_if(flags, l == 0 && !(fabsf(got - ref) <= 0.02f + 0.01f * fabsf(ref)), 8u, lane); }
        }
        GSYNC();
#endif
        { ARGS(); IDS(); ln_rows(ap->out, X1_, XN_, ap->in[9] + l * DM, ap->in[10] + l * DM, gw, NGW, lane); }
        GSYNC();
#if defined(DBG_CHECKS) && (DBG_CHECKS & 256)
        {
            ARGS(); IDS(); unsigned* flags = (unsigned*)(ws + WS_FLAGS);
            if (gw < 2048) { const unsigned h0 = hsh(gw * 2 + 13 + 67867967 * l); const int r = h0 % M; const float* z = ap->out + (size_t)r * DM;
                float sm = 0.f; for (int c = lane; c < DM; c += 64) sm += z[c]; sm = wave_sum(sm) * (1.f / DM);
                float sv = 0.f; for (int c = lane; c < DM; c += 64) { const float d = z[c] - sm; sv += d * d; } sv = wave_sum(sv) * (1.f / DM);
                const float rs = rsqrtf(sv + LN_EPS); float b1 = 0.f, b2 = 0.f;
                for (int c = lane; c < DM; c += 64) { const float y = (z[c] - sm) * rs * ap->in[9][l * DM + c] + ap->in[10][l * DM + c];
                    if (!(fabsf(X1_[(size_t)r * DM + c] - y) <= 0.002f + 0.002f * fabsf(y))) b1 = 1.f;
                    if (!(fabsf(bf2f(XN_[(size_t)r * DM + c]) - y) <= 0.01f + 0.01f * fabsf(y))) b2 = 1.f; }
                b1 = wave_sum(b1); b2 = wave_sum(b2);
                if (b1 > 0.f && lane == 0) atomicAdd(flags + 1, 1u); if (b2 > 0.f && lane == 0) atomicAdd(flags + 2, 1u); }
        }
        GSYNC();
#endif
#if defined(DBG_CHECKS) && (DBG_CHECKS & 64)
        {
            ARGS(); IDS(); unsigned* flags = (unsigned*)(ws + WS_FLAGS);
            if (gw < 2048) { const unsigned h0 = hsh(gw * 2 + 11 + 49979687 * l + 0); const int r = h0 % M; float bad = 0.f;
                for (int c = lane; c < DM; c += 64) { const float a = X1_[(size_t)r * DM + c], b = bf2f(XN_[(size_t)r * DM + c]); if (!(fabsf(a - b) <= 0.01f + 0.01f * fabsf(a))) bad = 1.f; }
                bad = wave_sum(bad); if (bad > 0.f && lane == 0) atomicAdd(flags + 1, 1u); if (bad > 512.f && lane == 0) atomicAdd(flags + 2, 1u); }
        }
        GSYNC();
#endif
        {
            ARGS(); IDS(); pg8::Gemm g{XN_, (const bf16raw*)(WL_ + WO_GU), M, NGU, DM}; pg8::StaticOrder S; S.init(M, NGU, G, bx);
            pg8::EpiConvGlu E{HH_, ap->in[13] + (size_t)l * 3 * FF, ap->in[14] + (size_t)l * FF, SIDE_};
            pg8::gemm_phase<pg8::EpiConvGlu, pg8::StaticOrder, true, true>(ldsp, g, S, E);
        }
        GSYNC();
#if defined(DBG_CHECKS) && (DBG_CHECKS & 64)
        {
            ARGS(); IDS(); unsigned* flags = (unsigned*)(ws + WS_FLAGS);
            if (gw < 2048) { const unsigned h0 = hsh(gw * 2 + 11 + 49979687 * l + 1); const int r = h0 % M; float bad = 0.f;
                for (int c = lane; c < DM; c += 64) { const float a = X1_[(size_t)r * DM + c], b = bf2f(XN_[(size_t)r * DM + c]); if (!(fabsf(a - b) <= 0.01f + 0.01f * fabsf(a))) bad = 1.f; }
                bad = wave_sum(bad); if (bad > 0.f && lane == 0) atomicAdd(flags + 1, 1u); if (bad > 512.f && lane == 0) atomicAdd(flags + 2, 1u); }
        }
        GSYNC();
#endif
        {
            ARGS(); IDS(); float* side = SIDE_; bf16raw* HH = HH_; const float* cw = ap->in[13] + (size_t)l * 3 * FF;
            for (int it = gt; it < 512 * 2 * (FF / 4); it += NGT) {
                const int f = 4 * (it % (FF / 4)), ct = it / (FF / 4), tb = ct & 1, c = ct >> 1;
                const int r = 64 * c + (tb ? 63 : 0), s = r & (SEQ - 1);
                f32x4 gc = *(const f32x4*)(side + ((size_t)ct * 3 + 0) * FF + f); const f32x4 uu = *(const f32x4*)(side + ((size_t)ct * 3 + 1) * FF + f);
                if (!tb && s != 0) { const f32x4 gn = *(const f32x4*)(side + ((size_t)((c - 1) * 2 + 1) * 3 + 2) * FF + f); gc += *(const f32x4*)(cw + f) * gn; }
                if (tb && s != SEQ - 1) { const f32x4 gn = *(const f32x4*)(side + ((size_t)((c + 1) * 2 + 0) * 3 + 2) * FF + f); gc += *(const f32x4*)(cw + 2 * FF + f) * gn; }
                v2u o; o.x = pk2(pg8::gelu_tanh(gc[0]) * uu[0], pg8::gelu_tanh(gc[1]) * uu[1]); o.y = pk2(pg8::gelu_tanh(gc[2]) * uu[2], pg8::gelu_tanh(gc[3]) * uu[3]);
                *(v2u*)(HH + (size_t)r * FF + f) = o;
            }
        }
        GSYNC();
#if defined(DBG_CHECKS) && (DBG_CHECKS & 8)
        {
            ARGS(); IDS(); unsigned* flags = (unsigned*)(ws + WS_FLAGS);
            if (gw < 512) { const unsigned h0 = hsh(gw * 2 + 5 + 15485863 * l); const int f = hsh(h0) % FF; int r = h0 % M;
                const int kind = gw & 7; if (kind == 0) r = (r & ~63); if (kind == 1) r = (r & ~63) + 63; if (kind == 2) r = (r & ~255); if (kind == 3) r = (r & ~255) + 255; if (kind == 4) r = (r & ~(SEQ - 1)); if (kind == 5) r = (r & ~(SEQ - 1)) + SEQ - 1;
                const int s = r & (SEQ - 1);
                const float* wg = ap->in[11] + (size_t)l * DM * FF; const float* wu = ap->in[12] + (size_t)l * DM * FF; const float* cw = ap->in[13] + (size_t)l * 3 * FF;
                float gc = ap->in[14][(size_t)l * FF + f];
                if (s > 0) gc += cw[f] * dot_aw(XN_ + (size_t)(r - 1) * DM, wg, f, FF, DM, lane);
                gc += cw[FF + f] * dot_aw(XN_ + (size_t)r * DM, wg, f, FF, DM, lane);
                if (s < SEQ - 1) gc += cw[2 * FF + f] * dot_aw(XN_ + (size_t)(r + 1) * DM, wg, f, FF, DM, lane);
                const float u = dot_aw(XN_ + (size_t)r * DM, wu, f, FF, DM, lane);
                const float yy = 0.7978845608f * (gc + 0.044715f * gc * gc * gc); const float th = 1.0f - 2.0f / (1.0f + __expf(2.0f * yy)); const float ref = 0.5f * gc * (1.0f + th) * u;
                const float got = bf2f(HH_[(size_t)r * FF + f]);
                flag_if(flags, !(fabsf(got - ref) <= 0.03f + 0.03f * fabsf(ref)), 16u, lane); }
        }
        GSYNC();
#endif
#if defined(DBG_CHECKS) && (DBG_CHECKS & 64)
        {
            ARGS(); IDS(); unsigned* flags = (unsigned*)(ws + WS_FLAGS);
            if (gw < 2048) { const unsigned h0 = hsh(gw * 2 + 11 + 49979687 * l + 2); const int r = h0 % M; float bad = 0.f;
                for (int c = lane; c < DM; c += 64) { const float a = X1_[(size_t)r * DM + c], b = bf2f(XN_[(size_t)r * DM + c]); if (!(fabsf(a - b) <= 0.01f + 0.01f * fabsf(a))) bad = 1.f; }
                bad = wave_sum(bad); if (bad > 0.f && lane == 0) atomicAdd(flags + 1, 1u); if (bad > 512.f && lane == 0) atomicAdd(flags + 2, 1u); }
        }
        GSYNC();
#endif
        {
            ARGS(); IDS(); pg8::Gemm g{HH_, (const bf16raw*)(WL_ + WO_DN), M, DM, FF}; pg8::StaticOrder S; S.init(M, DM, G, bx);
            pg8::EpiRes E{X1_, ap->out, DM, ALPHA, FFN_SCALE};
            pg8::gemm_phase<pg8::EpiRes, pg8::StaticOrder, true, true>(ldsp, g, S, E);
        }
        GSYNC();
#if defined(DBG_CHECKS) && (DBG_CHECKS & 16)
        {
            ARGS(); IDS(); unsigned* flags = (unsigned*)(ws + WS_FLAGS);
            if (gw < 512) { const unsigned h0 = hsh(gw * 2 + 9 + 32452843 * l); const int r = h0 % M, c = hsh(h0) % DM;
                const float ref = ALPHA * X1_[(size_t)r * DM + c] + dot_aw(HH_ + (size_t)r * FF, ap->in[15] + (size_t)l * FF * DM, c, DM, FF, lane);
                const float got = ap->out[(size_t)r * DM + c];
                if (!(fabsf(got - ref) <= 0.02f + 0.005f * fabsf(ref)) && lane == 0) atomicAdd(flags + 1, 1u); if (!(fabsf(got - ref) <= 0.3f) && lane == 0) atomicAdd(flags + 2, 1u); }
        }
        GSYNC();
#endif
        { ARGS(); IDS(); ln_rows(ap->out, ap->out, XN_, ap->in[16] + l * DM, ap->in[17] + l * DM, gw, NGW, lane); }
        if (l + 1 < DEPTH) GSYNC();
    }
#ifdef DBG_CHECKS
    GSYNC();
    { ARGS(); IDS(); if (gt == 0) { unsigned fl = __hip_atomic_load((unsigned*)(ws + WS_FLAGS), __ATOMIC_RELAXED, __HIP_MEMORY_SCOPE_AGENT); const unsigned cn = __hip_atomic_load((unsigned*)(ws + WS_FLAGS) + 1, __ATOMIC_RELAXED, __HIP_MEMORY_SCOPE_AGENT); if (cn >= 1) fl |= 32u; if (cn >= 16) fl |= 64u; if (cn >= 256) fl |= 128u; if (cn >= 900) fl |= 256u; { const unsigned c2 = __hip_atomic_load((unsigned*)(ws + WS_FLAGS) + 2, __ATOMIC_RELAXED, __HIP_MEMORY_SCOPE_AGENT); if (c2 >= 1) fl |= 512u; if (c2 >= 256) fl |= 1024u; } if (fl) ap->out[0] = 1.0e4f * (float)(1u + fl); } }
#endif
}

extern "C" void kernel_launch(void* const* d_in, const int* in_sizes, int n_in, void* d_out, int out_size, void* d_ws, size_t ws_size, hipStream_t stream) {
    static int grid = 0;
    if (grid == 0) {
        if (n_in != 18 || in_sizes[0] != M * DM || out_size != M * DM || ws_size < WS_END) { fprintf(stderr, "kernel_launch: unexpected shapes (n_in %d, in0 %d, out %d, ws %zu < %zu); nothing launched\n", n_in, n_in > 0 ? in_sizes[0] : -1, out_size, ws_size, (size_t)WS_END); grid = -1; return; }
        int dev = 0, cus = 0, per_cu = 0;
        if (hipGetDevice(&dev) != hipSuccess || hipDeviceGetAttribute(&cus, hipDeviceAttributeMultiprocessorCount, dev) != hipSuccess) { fprintf(stderr, "kernel_launch: device query failed\n"); grid = -1; return; }
        if (hipFuncSetAttribute((const void*)fwd_kernel, hipFuncAttributeMaxDynamicSharedMemorySize, LDS_BYTES) != hipSuccess) { fprintf(stderr, "kernel_launch: hipFuncSetAttribute failed\n"); grid = -1; return; }
        if (hipOccupancyMaxActiveBlocksPerMultiprocessor(&per_cu, (const void*)fwd_kernel, NTHR, LDS_BYTES) != hipSuccess || per_cu < 1) { fprintf(stderr, "kernel_launch: occupancy query says %d blocks per CU\n", per_cu); per_cu = 1; }
        (void)hipGetLastError();
        grid = cus * per_cu;
    }
    if (grid < 0) return;
    Args a{};
    for (int i = 0; i < 18; ++i) a.in[i] = (const float*)d_in[i];
    a.out = (float*)d_out; a.ws = (unsigned char*)d_ws;
    void* args[] = {&a};
    hipError_t e = hipLaunchCooperativeKernel((const void*)fwd_kernel, dim3(grid), dim3(NTHR), args, LDS_BYTES, stream);
    if (e != hipSuccess) fprintf(stderr, "kernel_launch: cooperative launch failed: %s (grid %d)\n", hipGetErrorString(e), grid);
}
```
